# Optimizing an MI355X kernel written in HIP

```python
import jax, jax.numpy as jnp
from jax import lax
import numpy as np

D_MODEL = 1024
BATCH = 8
SEQ = 4096
DEPTH = 1

N_META = 16
GRID_W = 64
MLA_HEADS = 8
MLA_NOPE = 64
MLA_ROPE = 32
MLA_V = 64
MLA_QK = MLA_NOPE + MLA_ROPE
Q_LORA = 384
KV_LORA = 256
NA_HEADS = 8
NA_HEAD_DIM = 64
NA_MAX_ROWS = 8
NA_KW = 16
D_FF = 2816
Q_BLOCK = 128
ROPE_THETA = 10000.0
EPS = 1e-6
MLA_WIDTH = MLA_HEADS * MLA_V
NA_WIDTH = NA_HEADS * NA_HEAD_DIM
IN_SPLITS = (Q_LORA, KV_LORA, MLA_ROPE, NA_WIDTH, NA_WIDTH, NA_WIDTH, D_MODEL, D_MODEL)
IN_WIDTH = Q_LORA + KV_LORA + MLA_ROPE + 3 * NA_WIDTH + 2 * D_MODEL

kernel_name = 'hybrid_mla_natten_macaron_block'


def rmsnorm(x, g):
    xf = x.astype(jnp.float32)
    y = xf * lax.rsqrt(jnp.mean(xf * xf, axis=-1, keepdims=True) + EPS)
    return (y * g.astype(jnp.float32)).astype(x.dtype)


def swiglu(x, w_gate, w_up, w_down):
    return (jax.nn.silu(x @ w_gate) * (x @ w_up)) @ w_down


def rope_tables(t_len):
    half = MLA_ROPE // 2
    pos = jnp.arange(t_len, dtype=jnp.float32)
    inv = ROPE_THETA ** (-jnp.arange(half, dtype=jnp.float32) / half)
    ang = pos[:, None] * inv[None, :]
    return jnp.cos(ang), jnp.sin(ang)


def apply_rope(x, cos, sin):
    half = MLA_ROPE // 2
    c = cos[None, :, None, :].astype(x.dtype)
    s = sin[None, :, None, :].astype(x.dtype)
    x1, x2 = x[..., :half], x[..., half:]
    return jnp.concatenate([x1 * c - x2 * s, x1 * s + x2 * c], axis=-1)


def dense_attend(q, k, v, scale):
    s = jnp.einsum('bqhd,bkhd->bhqk', q, k).astype(jnp.float32) * scale
    p = jax.nn.softmax(s, axis=-1).astype(v.dtype)
    return jnp.einsum('bhqk,bkhd->bqhd', p, v)


def mla_mixer(c_q, c_kv, k_r, q_a_norm, w_uq, kv_a_norm, w_ukv, q_head_norm, k_head_norm):
    b, t_len, _ = c_q.shape
    q = (rmsnorm(c_q, q_a_norm) @ w_uq).reshape(b, t_len, MLA_HEADS, MLA_QK)
    kv = (rmsnorm(c_kv, kv_a_norm) @ w_ukv).reshape(b, t_len, MLA_HEADS, MLA_NOPE + MLA_V)
    k_nope, v = kv[..., :MLA_NOPE], kv[..., MLA_NOPE:]
    k_rope = jnp.broadcast_to(k_r[:, :, None, :], (b, t_len, MLA_HEADS, MLA_ROPE))
    k = jnp.concatenate([k_nope, k_rope], axis=-1)
    q = rmsnorm(q, q_head_norm)
    k = rmsnorm(k, k_head_norm)
    cos, sin = rope_tables(t_len)
    q = jnp.concatenate([q[..., :MLA_NOPE], apply_rope(q[..., MLA_NOPE:], cos, sin)], axis=-1)
    k = jnp.concatenate([k[..., :MLA_NOPE], apply_rope(k[..., MLA_NOPE:], cos, sin)], axis=-1)
    scale = MLA_QK ** -0.5
    n_real = t_len - N_META
    o_meta = dense_attend(q[:, :N_META], k, v, scale).reshape(b, N_META, MLA_WIDTH)
    q_blocks = jnp.moveaxis(q[:, N_META:].reshape(b, n_real // Q_BLOCK, Q_BLOCK, MLA_HEADS, MLA_QK), 1, 0)
    o_real = lax.map(lambda qb: dense_attend(qb, k, v, scale), q_blocks)
    o_real = jnp.moveaxis(o_real, 0, 1).reshape(b, n_real, MLA_WIDTH)
    return jnp.concatenate([o_meta, o_real], axis=1)


def na_mixer(q, k, v, q_head_norm, k_head_norm, rel_bias):
    b, t_len, _ = q.shape
    q = rmsnorm(q.reshape(b, t_len, NA_HEADS, NA_HEAD_DIM), q_head_norm)
    k = rmsnorm(k.reshape(b, t_len, NA_HEADS, NA_HEAD_DIM), k_head_norm)
    v = v.reshape(b, t_len, NA_HEADS, NA_HEAD_DIM)
    scale = NA_HEAD_DIM ** -0.5
    n_real = t_len - N_META
    rows = n_real // GRID_W
    kh = min(NA_MAX_ROWS, rows)
    q_m, k_m, v_m = q[:, :N_META], k[:, :N_META], v[:, :N_META]
    qg = q[:, N_META:].reshape(b, rows, GRID_W, NA_HEADS, NA_HEAD_DIM)
    kg = k[:, N_META:].reshape(b, rows, GRID_W, NA_HEADS, NA_HEAD_DIM)
    vg = v[:, N_META:].reshape(b, rows, GRID_W, NA_HEADS, NA_HEAD_DIM)
    col_start = np.clip(np.arange(GRID_W) - NA_KW // 2, 0, GRID_W - NA_KW)
    col_idx = col_start[:, None] + np.arange(NA_KW)[None, :]
    dc = col_idx - np.arange(GRID_W)[:, None] + (NA_KW - 1)
    bias_cols = rel_bias[:, :, dc]
    o_meta = dense_attend(q_m, k_m, v_m, scale).reshape(b, N_META, NA_WIDTH)

    def row_block(r):
        rs = jnp.clip(r - kh // 2, 0, rows - kh)
        q_row = lax.dynamic_index_in_dim(qg, r, axis=1, keepdims=False)
        k_win = lax.dynamic_slice_in_dim(kg, rs, kh, axis=1)[:, :, col_idx]
        v_win = lax.dynamic_slice_in_dim(vg, rs, kh, axis=1)[:, :, col_idx]
        dr = rs + jnp.arange(kh) - r + (NA_MAX_ROWS - 1)
        bias = jnp.transpose(bias_cols[:, dr], (0, 2, 1, 3)).reshape(NA_HEADS, GRID_W, kh * NA_KW)
        s_win = jnp.einsum('bchd,bicjhd->bhcij', q_row, k_win).reshape(b, NA_HEADS, GRID_W, kh * NA_KW)
        s_win = s_win.astype(jnp.float32) * scale + bias.astype(jnp.float32)[None]
        s_meta = jnp.einsum('bchd,bmhd->bhcm', q_row, k_m).astype(jnp.float32) * scale
        p = jax.nn.softmax(jnp.concatenate([s_meta, s_win], axis=-1), axis=-1).astype(v.dtype)
        p_meta = p[..., :N_META]
        p_win = p[..., N_META:].reshape(b, NA_HEADS, GRID_W, kh, NA_KW)
        return (jnp.einsum('bhcm,bmhd->bchd', p_meta, v_m)
                + jnp.einsum('bhcij,bicjhd->bchd', p_win, v_win))

    o_real = lax.map(row_block, jnp.arange(rows))
    o_real = jnp.moveaxis(o_real, 0, 1).reshape(b, n_real, NA_WIDTH)
    return jnp.concatenate([o_meta, o_real], axis=1)


def setup_inputs(seed: int = 0) -> dict:
    key = jax.random.key(seed)
    ks = jax.random.split(key, 24)

    def dense(k, shape, fan_in):
        return jax.random.normal(k, shape, jnp.float32) * fan_in ** -0.5

    def gain(k, shape):
        return 1.0 + 0.02 * jax.random.normal(k, shape, jnp.float32)

    L = DEPTH
    return {
        'x': jax.random.normal(ks[0], (BATCH, SEQ, D_MODEL), jnp.float32),
        'meta_tokens': jax.random.normal(ks[1], (N_META, D_MODEL), jnp.float32),
        'ffn1_norm': gain(ks[2], (L, D_MODEL)),
        'ffn1_w_gate': dense(ks[3], (L, D_MODEL, D_FF), D_MODEL),
        'ffn1_w_up': dense(ks[4], (L, D_MODEL, D_FF), D_MODEL),
        'ffn1_w_down': dense(ks[5], (L, D_FF, D_MODEL), D_FF),
        'mix_norm': gain(ks[6], (L, D_MODEL)),
        'w_in': dense(ks[7], (L, D_MODEL, IN_WIDTH), D_MODEL),
        'mla_q_a_norm': gain(ks[8], (L, Q_LORA)),
        'mla_w_uq': dense(ks[9], (L, Q_LORA, MLA_HEADS * MLA_QK), Q_LORA),
        'mla_kv_a_norm': gain(ks[10], (L, KV_LORA)),
        'mla_w_ukv': dense(ks[11], (L, KV_LORA, MLA_HEADS * (MLA_NOPE + MLA_V)), KV_LORA),
        'mla_q_head_norm': gain(ks[12], (L, MLA_QK)),
        'mla_k_head_norm': gain(ks[13], (L, MLA_QK)),
        'na_q_head_norm': gain(ks[14], (L, NA_HEAD_DIM)),
        'na_k_head_norm': gain(ks[15], (L, NA_HEAD_DIM)),
        'na_rel_bias': 0.02 * jax.random.normal(ks[16], (L, NA_HEADS, 2 * NA_MAX_ROWS - 1, 2 * NA_KW - 1), jnp.float32),
        'w_branch_a': dense(ks[17], (L, MLA_WIDTH, D_MODEL), MLA_WIDTH),
        'w_branch_b': dense(ks[18], (L, NA_WIDTH, D_MODEL), NA_WIDTH),
        'w_out': dense(ks[19], (L, D_MODEL, D_MODEL), D_MODEL),
        'ffn2_norm': gain(ks[20], (L, D_MODEL)),
        'ffn2_w_gate': dense(ks[21], (L, D_MODEL, D_FF), D_MODEL),
        'ffn2_w_up': dense(ks[22], (L, D_MODEL, D_FF), D_MODEL),
        'ffn2_w_down': dense(ks[23], (L, D_FF, D_MODEL), D_FF),
    }


def reference(x, meta_tokens, ffn1_norm, ffn1_w_gate, ffn1_w_up, ffn1_w_down, mix_norm, w_in,
              mla_q_a_norm, mla_w_uq, mla_kv_a_norm, mla_w_ukv, mla_q_head_norm, mla_k_head_norm,
              na_q_head_norm, na_k_head_norm, na_rel_bias, w_branch_a, w_branch_b, w_out,
              ffn2_norm, ffn2_w_gate, ffn2_w_up, ffn2_w_down):
    b = x.shape[0]
    split_points = np.cumsum(IN_SPLITS)[:-1].tolist()
    meta = jnp.broadcast_to(meta_tokens.astype(x.dtype)[None], (b, N_META, D_MODEL))
    h = jnp.concatenate([meta, x], axis=1)
    for l in range(DEPTH):
        h = h + 0.5 * swiglu(rmsnorm(h, ffn1_norm[l]), ffn1_w_gate[l], ffn1_w_up[l], ffn1_w_down[l])
        xn = rmsnorm(h, mix_norm[l])
        proj = xn @ w_in[l]
        c_q, c_kv, k_r, q_na, k_na, v_na, g_a, g_b = jnp.split(proj, split_points, axis=-1)
        o_a = mla_mixer(c_q, c_kv, k_r, mla_q_a_norm[l], mla_w_uq[l], mla_kv_a_norm[l], mla_w_ukv[l],
                        mla_q_head_norm[l], mla_k_head_norm[l])
        o_b = na_mixer(q_na, k_na, v_na, na_q_head_norm[l], na_k_head_norm[l], na_rel_bias[l])
        merged = jax.nn.sigmoid(g_a) * (o_a @ w_branch_a[l]) + jax.nn.sigmoid(g_b) * (o_b @ w_branch_b[l])
        h = h + merged @ w_out[l]
        h = h + 0.5 * swiglu(rmsnorm(h, ffn2_norm[l]), ffn2_w_gate[l], ffn2_w_up[l], ffn2_w_down[l])
    return h[:, N_META:]
```

```cpp
#include <hip/hip_runtime.h>
#include <hip/hip_cooperative_groups.h>
#include <cstdio>
#include <cstdint>
namespace cg = cooperative_groups;

#define LAS __attribute__((address_space(3)))
typedef unsigned short bf16_t;
typedef short bf16x8 __attribute__((ext_vector_type(8)));
typedef float f32x4 __attribute__((ext_vector_type(4)));
typedef float f32x16 __attribute__((ext_vector_type(16)));
typedef float f32x2 __attribute__((ext_vector_type(2)));
typedef unsigned u32x4 __attribute__((ext_vector_type(4)));
typedef unsigned u32x2 __attribute__((ext_vector_type(2)));
typedef __bf16 bf16x2_t __attribute__((ext_vector_type(2)));

constexpr int M = 32768, DM = 1024, FF = 2816, TSEQ = 4096, NBATCH = 8;
constexpr float EPS = 1e-6f;
constexpr float LOG2E = 1.4426950408889634f;
constexpr float QSC_MLA = 0.10206207261596575f * LOG2E;
constexpr float QSC_NA = 0.125f * LOG2E;

__device__ __forceinline__ unsigned pk2(float lo, float hi) { f32x2 v = {lo, hi}; bf16x2_t b = __builtin_convertvector(v, bf16x2_t); return __builtin_bit_cast(unsigned, b); }
__device__ __forceinline__ float bf2f(unsigned short h) { return __uint_as_float(((unsigned)h) << 16); }
__device__ __forceinline__ void st16(bf16_t* p, f32x4 a, f32x4 b) { u32x4 w; w.x = pk2(a[0], a[1]); w.y = pk2(a[2], a[3]); w.z = pk2(b[0], b[1]); w.w = pk2(b[2], b[3]); *(u32x4*)p = w; }
__device__ __forceinline__ float sumsq4(f32x4 a) { return (a[0] * a[0] + a[1] * a[1]) + (a[2] * a[2] + a[3] * a[3]); }
__device__ __forceinline__ float sum4(f32x4 a) { return (a[0] + a[1]) + (a[2] + a[3]); }
__device__ __forceinline__ float sumN16(const float* p) { return (sum4(*(const f32x4*)p) + sum4(*(const f32x4*)(p + 4))) + (sum4(*(const f32x4*)(p + 8)) + sum4(*(const f32x4*)(p + 12))); }
__device__ __forceinline__ float sumN8(const float* p) { return sum4(*(const f32x4*)p) + sum4(*(const f32x4*)(p + 4)); }
__device__ __forceinline__ float sumN4(const float* p) { return sum4(*(const f32x4*)p); }
template <int N> __device__ __forceinline__ float sumN(const float* p) { if constexpr (N == 16) return sumN16(p); else if constexpr (N == 8) return sumN8(p); else return sumN4(p); }
__device__ __forceinline__ float silu_f(float g) { return g * __builtin_amdgcn_rcpf(1.f + __builtin_amdgcn_exp2f(-LOG2E * g)); }
__device__ __forceinline__ float sigm_f(float g) { return __builtin_amdgcn_rcpf(1.f + __builtin_amdgcn_exp2f(-LOG2E * g)); }
__device__ __forceinline__ float ld_agent(const float* p) { return __hip_atomic_load(p, __ATOMIC_RELAXED, __HIP_MEMORY_SCOPE_AGENT); }
__device__ __forceinline__ float wave_sum(float v) {
#pragma unroll
    for (int o = 1; o < 64; o <<= 1) v += __shfl_xor(v, o);
    return v;
}

namespace pg8 {
#define PG8_LAS __attribute__((address_space(3)))
constexpr int BM = 256, BK = 64, HALF = 128, HTB = HALF * BK * 2, STAGE_BYTES = 8 * HTB, NXCD = 8, WGM = 8;
__host__ __device__ __forceinline__ int lds_byte(int r, int c) { const int st = (r >> 4) * 2 + (c >> 5), rr = r & 15, cc = c & 31, ob = rr * 64 + cc * 2; return st * 1024 + (ob ^ (((ob >> 9) & 1) << 5)); }
__host__ __device__ __forceinline__ void stage_rc(int b, int& R, int& C) { const int st = b / 1024, sb = b % 1024, swz = sb ^ (((sb >> 9) & 1) << 5); R = (st >> 1) * 16 + swz / 64; C = (st & 1) * 32 + (swz % 64) / 2; }
__host__ __device__ __forceinline__ int perm32(int rho) { const int n = rho >> 4, i = rho & 15; return 8 * (i >> 2) + 4 * n + (i & 3); }
struct Unit { int pm, pn; };
struct Gemm { const bf16_t* A; const bf16_t* Bt; int lda, ldb, K; };
struct StaticOrder {
    int nM, nN, nwg, G, c;
    __device__ void init(int nM_, int nN_, int G_, int c_) { nM = nM_; nN = nN_; nwg = nM * nN; G = G_; c = c_; }
    __device__ bool next(int i, Unit& u) const {
        const long L = (long)i * G + c; if (L >= nwg) return false;
        int wgid = (int)L; { const int q = nwg / NXCD, r = nwg % NXCD, xcd = wgid % NXCD, off = wgid / NXCD; wgid = (xcd < r ? xcd * (q + 1) : r * (q + 1) + (xcd - r) * q) + off; }
        const int nig = WGM * nN, gid = wgid / nig, fm = gid * WGM, gsz = (nM - fm) < WGM ? (nM - fm) : WGM;
        u.pm = fm + ((wgid % nig) % gsz); u.pn = (wgid % nig) / gsz; return true;
    }
    __device__ __forceinline__ void a_ready(const Unit&) const {}
    __device__ __forceinline__ void done(const Unit&) const {}
};
template <class Epi, class Sched, bool ALIGN_EPI = false, bool SP2 = false>
__device__ __forceinline__ void gemm_phase(PG8_LAS unsigned char* lds, const Gemm g, const Sched& S, const Epi& E) {
    int tid_ = threadIdx.x; asm volatile("" : "+v"(tid_));
    const int tid = tid_, wid = __builtin_amdgcn_readfirstlane(tid >> 6), lane = tid & 63, wr = wid >> 2, wc = wid & 3, fr = lane & 15, fq = lane >> 4;
    const int K = g.K, nt = K / BK;
    unsigned voffA[2], voffB[2];
#pragma unroll
    for (int i = 0; i < 2; ++i) { int R, C; stage_rc(tid * 16 + i * 8192, R, C); const int Rb = Epi::PERM ? ((R & ~31) + perm32(R & 31)) : R;
        voffA[i] = (unsigned)(R * g.lda + C) * 2u; voffB[i] = (unsigned)(Rb * g.ldb + C) * 2u; }
    const size_t kstep = (size_t)(BK * 2);
    const size_t hstepA = (size_t)HALF * g.lda * 2, hstepB = (size_t)HALF * g.ldb * 2;
    const size_t tstepA = 2 * hstepA, tstepB = 2 * hstepB;
    const unsigned ldsw = (unsigned)wid * 1024u;
    const int aoff = lds_byte(wr * 64 + fr, fq * 8), boff = lds_byte(wc * 32 + fr, fq * 8);
#define PG8_SA(b, h) (((b) * 2 + (h)) * HTB)
#define PG8_SB(b, h) ((4 + (b) * 2 + (h)) * HTB)
#define PG8_STAGE(bufoff, gbase, voff) do { _Pragma("unroll") for (int _i = 0; _i < 2; ++_i) \
        __builtin_amdgcn_global_load_lds((const unsigned*)((const char*)(gbase) + (voff)[_i]), (PG8_LAS unsigned*)(lds + (bufoff) + ldsw + _i * 8192), 16, 0, 0); } while (0)
#define PG8_LDA(dst, b, h) do { _Pragma("unroll") for (int m = 0; m < 4; ++m) _Pragma("unroll") for (int k = 0; k < 2; ++k) dst[m][k] = *(const PG8_LAS bf16x8*)(lds + PG8_SA(b, h) + aoff + m * 2048 + k * 1024); } while (0)
#define PG8_LDB(dst, b, h) do { _Pragma("unroll") for (int n = 0; n < 2; ++n) _Pragma("unroll") for (int k = 0; k < 2; ++k) dst[n][k] = *(const PG8_LAS bf16x8*)(lds + PG8_SB(b, h) + boff + n * 2048 + k * 1024); } while (0)
#define PG8_MMA(ai, bj, At, Bt) do { __builtin_amdgcn_s_setprio(1); _Pragma("unroll") for (int m = 0; m < 4; ++m) _Pragma("unroll") for (int n = 0; n < 2; ++n) _Pragma("unroll") for (int k = 0; k < 2; ++k) \
        acc[ai][bj][m][n] = __builtin_amdgcn_mfma_f32_16x16x32_bf16(Bt[n][k], At[m][k], acc[ai][bj][m][n], 0, 0, 0); __builtin_amdgcn_s_setprio(0); } while (0)
#define PG8_WAIT_V(n) asm volatile("s_waitcnt vmcnt(" #n ")" ::: "memory")
#define PG8_WAIT_L(n) asm volatile("s_waitcnt lgkmcnt(" #n ")" ::: "memory")
#define PG8_BAR __builtin_amdgcn_s_barrier()
#define PG8_SCHED __builtin_amdgcn_sched_barrier(0)
    Unit cur, nxt; int ui = 0;
    if (!S.next(0, cur)) return;
    f32x4 acc[2][2][4][2];
#pragma unroll
    for (int a = 0; a < 2; ++a)
#pragma unroll
        for (int b = 0; b < 2; ++b)
#pragma unroll
            for (int m = 0; m < 4; ++m)
#pragma unroll
                for (int n = 0; n < 2; ++n) acc[a][b][m][n] = (f32x4){0.f, 0.f, 0.f, 0.f};
    bf16x8 At[4][2], B0[2][2], B1[2][2];
    const char* cA = (const char*)g.A + (size_t)cur.pm * tstepA; const char* cB = (const char*)g.Bt + (size_t)cur.pn * tstepB;
    S.a_ready(cur);
    if constexpr (SP2) {
        PG8_STAGE(PG8_SB(0, 0), cB, voffB); PG8_STAGE(PG8_SB(0, 1), cB + hstepB, voffB); PG8_STAGE(PG8_SA(0, 0), cA, voffA); PG8_STAGE(PG8_SA(0, 1), cA + hstepA, voffA);
        if (wr == 1) PG8_BAR;
        PG8_WAIT_V(2); PG8_BAR;
        PG8_STAGE(PG8_SB(1, 0), cB + kstep, voffB); PG8_STAGE(PG8_SA(1, 0), cA + kstep, voffA); PG8_STAGE(PG8_SB(1, 1), cB + hstepB + kstep, voffB);
        PG8_WAIT_V(6); PG8_BAR;
    } else {
        PG8_STAGE(PG8_SB(0, 0), cB, voffB); PG8_STAGE(PG8_SA(0, 0), cA, voffA); PG8_STAGE(PG8_SB(0, 1), cB + hstepB, voffB); PG8_STAGE(PG8_SA(0, 1), cA + hstepA, voffA);
        if (wr == 1) PG8_BAR;
        PG8_WAIT_V(4); PG8_BAR;
        PG8_STAGE(PG8_SB(1, 0), cB + kstep, voffB); PG8_STAGE(PG8_SA(1, 0), cA + kstep, voffA); PG8_STAGE(PG8_SB(1, 1), cB + hstepB + kstep, voffB);
        PG8_WAIT_V(6); PG8_BAR;
    }
    for (;;) {
        const bool has_next = S.next(ui + 1, nxt);
        const char* nA = has_next ? (const char*)g.A + (size_t)nxt.pm * tstepA : cA; const char* nB = has_next ? (const char*)g.Bt + (size_t)nxt.pn * tstepB : cB;
        for (int t = 0; t < nt; t += 2) {
            const bool last = (t == nt - 2);
            const char* a1 = cA + (size_t)(t + 1) * kstep;
            const char* a2 = last ? nA : cA + (size_t)(t + 2) * kstep; const char* b2 = last ? nB : cB + (size_t)(t + 2) * kstep;
            const char* a3 = a2 + kstep; const char* b3 = b2 + kstep;
            if (last && has_next) S.a_ready(nxt);
            if constexpr (SP2) {
            PG8_LDB(B0, 0, 0); PG8_LDB(B1, 0, 1); PG8_SCHED; PG8_LDA(At, 0, 0); PG8_STAGE(PG8_SA(1, 1), a1 + hstepA, voffA);
            PG8_WAIT_V(8); PG8_WAIT_L(0); PG8_BAR; PG8_MMA(0, 0, At, B0); PG8_MMA(0, 1, At, B1); PG8_BAR; PG8_SCHED;
            PG8_LDA(At, 0, 1); PG8_STAGE(PG8_SB(0, 0), b2, voffB); PG8_STAGE(PG8_SB(0, 1), b2 + hstepB, voffB); PG8_STAGE(PG8_SA(0, 0), a2, voffA);
            PG8_WAIT_V(8); PG8_WAIT_L(0); PG8_BAR; PG8_MMA(1, 0, At, B0); PG8_MMA(1, 1, At, B1); PG8_BAR; PG8_SCHED;
            PG8_LDB(B0, 1, 0); PG8_LDB(B1, 1, 1); PG8_SCHED; PG8_LDA(At, 1, 0); PG8_STAGE(PG8_SA(0, 1), a2 + hstepA, voffA);
            PG8_WAIT_V(8); PG8_WAIT_L(0); PG8_BAR; PG8_MMA(0, 0, At, B0); PG8_MMA(0, 1, At, B1); PG8_BAR; PG8_SCHED;
            PG8_LDA(At, 1, 1); PG8_STAGE(PG8_SB(1, 0), b3, voffB); PG8_STAGE(PG8_SB(1, 1), b3 + hstepB, voffB); PG8_STAGE(PG8_SA(1, 0), a3, voffA);
            PG8_WAIT_V(8); PG8_WAIT_L(0); PG8_BAR; PG8_MMA(1, 0, At, B0); PG8_MMA(1, 1, At, B1); PG8_BAR; PG8_SCHED;
            } else {
            PG8_LDB(B0, 0, 0); PG8_SCHED; PG8_LDA(At, 0, 0); PG8_STAGE(PG8_SA(1, 1), a1 + hstepA, voffA);
            PG8_WAIT_L(8); PG8_BAR; PG8_WAIT_L(0); PG8_MMA(0, 0, At, B0); PG8_BAR; PG8_SCHED;
            PG8_LDB(B1, 0, 1); PG8_STAGE(PG8_SB(0, 0), b2, voffB);
            PG8_BAR; PG8_WAIT_L(0); PG8_MMA(0, 1, At, B1); PG8_BAR;
            PG8_LDA(At, 0, 1); PG8_STAGE(PG8_SA(0, 0), a2, voffA);
            PG8_BAR; PG8_WAIT_L(0); PG8_MMA(1, 0, At, B0); PG8_BAR; PG8_SCHED;
            PG8_STAGE(PG8_SB(0, 1), b2 + hstepB, voffB);
            PG8_WAIT_V(6); PG8_BAR; PG8_MMA(1, 1, At, B1); PG8_BAR;
            PG8_LDB(B0, 1, 0); PG8_SCHED; PG8_LDA(At, 1, 0); PG8_STAGE(PG8_SA(0, 1), a2 + hstepA, voffA);
            PG8_WAIT_L(8); PG8_BAR; PG8_WAIT_L(0); PG8_MMA(0, 0, At, B0); PG8_BAR; PG8_SCHED;
            PG8_LDB(B1, 1, 1); PG8_STAGE(PG8_SB(1, 0), b3, voffB);
            PG8_BAR; PG8_WAIT_L(0); PG8_MMA(0, 1, At, B1); PG8_BAR;
            PG8_LDA(At, 1, 1); PG8_STAGE(PG8_SA(1, 0), a3, voffA);
            PG8_BAR; PG8_WAIT_L(0); PG8_MMA(1, 0, At, B0); PG8_BAR; PG8_SCHED;
            PG8_STAGE(PG8_SB(1, 1), b3 + hstepB, voffB);
            PG8_WAIT_V(6); PG8_BAR; PG8_MMA(1, 1, At, B1); PG8_BAR;
            }
        }
        if constexpr (ALIGN_EPI) { if (wr == 0) PG8_BAR; }
        if constexpr (!Epi::AFTER_DRAIN) { int t2_ = threadIdx.x; asm volatile("" : "+v"(t2_)); E(acc, cur, wr, wc, t2_ & 15, (t2_ & 63) >> 4); S.done(cur); }
        if (!has_next) break;
#pragma unroll
        for (int a = 0; a < 2; ++a)
#pragma unroll
            for (int b = 0; b < 2; ++b)
#pragma unroll
                for (int m = 0; m < 4; ++m)
#pragma unroll
                    for (int n = 0; n < 2; ++n) acc[a][b][m][n] = (f32x4){0.f, 0.f, 0.f, 0.f};
        cur = nxt; cA = nA; cB = nB; ++ui;
        if constexpr (ALIGN_EPI) { if (wr == 1) PG8_BAR; }
    }
    PG8_WAIT_V(0);
    if constexpr (!ALIGN_EPI) { if (wr == 0) PG8_BAR; }
    PG8_BAR;
    if constexpr (Epi::AFTER_DRAIN) { E.fused(acc, cur, wr, wc, fr, fq, lds, wid, lane); S.done(cur); }
#undef PG8_SA
#undef PG8_SB
#undef PG8_STAGE
#undef PG8_LDA
#undef PG8_LDB
#undef PG8_MMA
#undef PG8_WAIT_V
#undef PG8_WAIT_L
#undef PG8_BAR
#undef PG8_SCHED
}
}
using pg8::Unit;
typedef const f32x4 (&AccRef)[2][2][4][2];
#define EPI_COMMON static constexpr bool PERM = true, AFTER_DRAIN = false;

constexpr int RS_TAB_OFF = 131072 + 4096;
__device__ __forceinline__ const LAS float* rs_table(const float* ssqp, int pm, int& cpm, LAS unsigned char* ldsbase) {
    LAS float* tab = (LAS float*)(ldsbase + RS_TAB_OFF);
    if (pm != cpm) { cpm = pm; int t = threadIdx.x; asm volatile("" : "+v"(t));
        if (t < 256) tab[t] = __builtin_amdgcn_rsqf(sumN16(ssqp + ((size_t)pm * 256 + t) * 16) * (1.f / 1024.f) + EPS);
        asm volatile("s_waitcnt lgkmcnt(0)" ::: "memory"); __builtin_amdgcn_s_barrier(); asm volatile("" ::: "memory"); }
    return tab;
}
struct EpiSwiGLU { EPI_COMMON
    bf16_t* O; const float* ssqp; LAS unsigned char* ldsb; mutable int cpm;
    __device__ __forceinline__ void operator()(AccRef acc, const Unit& u, int wr, int wc, int fr, int fq) const {
        const int row0 = u.pm * 256 + wr * 64 + fr, col0 = u.pn * 128 + wc * 32 + 8 * fq;
        const LAS float* tab = nullptr; if (ssqp) tab = rs_table(ssqp, u.pm, cpm, ldsb);
#pragma unroll
        for (int ai = 0; ai < 2; ++ai)
#pragma unroll
            for (int m = 0; m < 4; ++m) {
                const int row = row0 + ai * 128 + m * 16;
                const float rs = ssqp ? tab[ai * 128 + wr * 64 + m * 16 + fr] : 1.f;
                f32x4 o[2];
#pragma unroll
                for (int n = 0; n < 2; ++n)
#pragma unroll
                    for (int i = 0; i < 4; ++i) o[n][i] = silu_f(acc[ai][0][m][n][i] * rs) * (acc[ai][1][m][n][i] * rs);
                st16(O + (size_t)row * FF + col0, o[0], o[1]);
            }
    }
};
struct EpiResid { EPI_COMMON
    const void* base; int base_bf16; float* out; bf16_t* hb; float* ssqp; float alpha;
    __device__ __forceinline__ void operator()(AccRef acc, const Unit& u, int wr, int wc, int fr, int fq) const {
        const int row0 = u.pm * 256 + wr * 64 + fr, col0 = u.pn * 256 + wc * 32 + 8 * fq;
#pragma unroll
        for (int ai = 0; ai < 2; ++ai)
#pragma unroll
            for (int m = 0; m < 4; ++m) {
                const int row = row0 + ai * 128 + m * 16; float s = 0.f;
#pragma unroll
                for (int bj = 0; bj < 2; ++bj) {
                    const size_t off = (size_t)row * DM + col0 + bj * 128;
                    f32x4 b0, b1;
                    if (base_bf16) { const u32x4 p = *(const u32x4*)((const bf16_t*)base + off);
                        b0[0] = __uint_as_float(p.x << 16); b0[1] = __uint_as_float(p.x & 0xffff0000u); b0[2] = __uint_as_float(p.y << 16); b0[3] = __uint_as_float(p.y & 0xffff0000u);
                        b1[0] = __uint_as_float(p.z << 16); b1[1] = __uint_as_float(p.z & 0xffff0000u); b1[2] = __uint_as_float(p.w << 16); b1[3] = __uint_as_float(p.w & 0xffff0000u); }
                    else { b0 = *(const f32x4*)((const float*)base + off); b1 = *(const f32x4*)((const float*)base + off + 4); }
                    const f32x4 v0 = b0 + alpha * acc[ai][bj][m][0], v1 = b1 + alpha * acc[ai][bj][m][1];
                    if (out) { __builtin_nontemporal_store(v0, (f32x4*)(out + off)); __builtin_nontemporal_store(v1, (f32x4*)(out + off + 4)); }
                    if (hb) st16(hb + off, v0, v1);
                    s += sumsq4(v0) + sumsq4(v1);
                }
                if (ssqp) { s += __shfl_xor(s, 16); s += __shfl_xor(s, 32); if (fq == 0) ssqp[(size_t)row * 16 + u.pn * 4 + wc] = s; }
            }
    }
};
struct EpiProj { EPI_COMMON
    const float* ssqp; bf16_t *cq, *ckv, *qn, *kn, *sga, *sgb; float *cqs, *ckvs; const float *qg, *kg; LAS unsigned char* ldsb; mutable int cpm;
    __device__ __forceinline__ void operator()(AccRef acc, const Unit& u, int wr, int wc, int fr, int fq) const {
        const int row0 = u.pm * 256 + wr * 64 + fr, pn = u.pn;
        const LAS float* tab = rs_table(ssqp, u.pm, cpm, ldsb);
#pragma unroll
        for (int ai = 0; ai < 2; ++ai)
#pragma unroll
            for (int m = 0; m < 4; ++m) {
                const int row = row0 + ai * 128 + m * 16;
                const float rs = tab[ai * 128 + wr * 64 + m * 16 + fr];
                f32x4 v[2][2];
#pragma unroll
                for (int bj = 0; bj < 2; ++bj)
#pragma unroll
                    for (int n = 0; n < 2; ++n) v[bj][n] = acc[ai][bj][m][n] * rs;
                if (pn <= 2) {
                    bf16_t* dst = pn < 2 ? cq + (size_t)row * 512 + pn * 256 : ckv + (size_t)row * 256;
#pragma unroll
                    for (int bj = 0; bj < 2; ++bj) st16(dst + bj * 128 + wc * 32 + 8 * fq, v[bj][0], v[bj][1]);
                    float s = sumsq4(v[0][0]) + sumsq4(v[0][1]); if (pn != 1) s += sumsq4(v[1][0]) + sumsq4(v[1][1]);
                    s += __shfl_xor(s, 16); s += __shfl_xor(s, 32);
                    if (fq == 0) { if (pn < 2) cqs[(size_t)row * 8 + pn * 4 + wc] = s; else ckvs[(size_t)row * 4 + wc] = s; }
                } else if (pn <= 6) {
                    const bool isq = pn <= 4; const int head = 4 * (isq ? pn - 3 : pn - 5) + wc;
                    float s = (sumsq4(v[0][0]) + sumsq4(v[0][1])) + (sumsq4(v[1][0]) + sumsq4(v[1][1]));
                    s += __shfl_xor(s, 16); s += __shfl_xor(s, 32);
                    const float hr = __builtin_amdgcn_rsqf(s * (1.f / 64.f) + EPS) * (isq ? QSC_NA : 1.f);
                    const float* gain = isq ? qg : kg; bf16_t* dst = (isq ? qn : kn) + (size_t)row * 512 + 64 * head;
#pragma unroll
                    for (int bj = 0; bj < 2; ++bj) { const int d0 = 32 * bj + 8 * fq; const f32x4 g0 = *(const f32x4*)(gain + d0), g1 = *(const f32x4*)(gain + d0 + 4);
                        st16(dst + d0, v[bj][0] * hr * g0, v[bj][1] * hr * g1); }
                } else {
                    const int t = pn - 7; bf16_t* dst = (t < 4 ? sga : sgb) + (size_t)row * DM + (t & 3) * 256 + wc * 32 + 8 * fq;
#pragma unroll
                    for (int bj = 0; bj < 2; ++bj) { f32x4 a, b;
#pragma unroll
                        for (int i = 0; i < 4; ++i) { a[i] = sigm_f(v[bj][0][i]); b[i] = sigm_f(v[bj][1][i]); }
                        st16(dst + bj * 128, a, b); }
                }
            }
    }
};
template <int NST> struct EpiColT { EPI_COMMON
    bf16_t* O; int ldo; const float* st; float inv_n;
    __device__ __forceinline__ void operator()(AccRef acc, const Unit& u, int wr, int wc, int fr, int fq) const {
        const int row0 = u.pm * 256 + wr * 64 + fr, tok0 = u.pn * 256 + wc * 32 + 8 * fq;
#pragma unroll
        for (int bj = 0; bj < 2; ++bj)
#pragma unroll
            for (int n = 0; n < 2; ++n) {
                float cs[4];
#pragma unroll
                for (int e = 0; e < 4; ++e) cs[e] = __builtin_amdgcn_rsqf(sumN<NST>(st + (size_t)(tok0 + bj * 128 + 4 * n + e) * NST) * inv_n + EPS);
#pragma unroll
                for (int ai = 0; ai < 2; ++ai)
#pragma unroll
                    for (int m = 0; m < 4; ++m) {
                        const int row = row0 + ai * 128 + m * 16; u32x2 w;
                        w.x = pk2(acc[ai][bj][m][n][0] * cs[0], acc[ai][bj][m][n][1] * cs[1]); w.y = pk2(acc[ai][bj][m][n][2] * cs[2], acc[ai][bj][m][n][3] * cs[3]);
                        *(u32x2*)(O + (size_t)row * ldo + tok0 + bj * 128 + 4 * n) = w;
                    }
            }
    }
};
template <int NST> struct EpiRowScale { EPI_COMMON
    bf16_t* O; int ldo; const float* st; float inv_n;
    __device__ __forceinline__ void operator()(AccRef acc, const Unit& u, int wr, int wc, int fr, int fq) const {
        const int row0 = u.pm * 256 + wr * 64 + fr, col0 = u.pn * 256 + wc * 32 + 8 * fq;
#pragma unroll
        for (int ai = 0; ai < 2; ++ai)
#pragma unroll
            for (int m = 0; m < 4; ++m) {
                const int row = row0 + ai * 128 + m * 16;
                const float rs = __builtin_amdgcn_rsqf(sumN<NST>(st + (size_t)row * NST) * inv_n + EPS);
#pragma unroll
                for (int bj = 0; bj < 2; ++bj) st16(O + (size_t)row * ldo + col0 + bj * 128, acc[ai][bj][m][0] * rs, acc[ai][bj][m][1] * rs);
            }
    }
};
struct EpiGate { EPI_COMMON
    bf16_t* merged; const bf16_t* sg; int second;
    __device__ __forceinline__ void operator()(AccRef acc, const Unit& u, int wr, int wc, int fr, int fq) const {
        const int row0 = u.pm * 256 + wr * 64 + fr, col0 = u.pn * 256 + wc * 32 + 8 * fq;
#pragma unroll
        for (int ai = 0; ai < 2; ++ai)
#pragma unroll
            for (int m = 0; m < 4; ++m) {
                const int row = row0 + ai * 128 + m * 16;
#pragma unroll
                for (int bj = 0; bj < 2; ++bj) {
                    const size_t off = (size_t)row * DM + col0 + bj * 128;
                    const u32x4 g = *(const u32x4*)(sg + off);
                    f32x4 a, b;
                    a[0] = __uint_as_float(g.x << 16) * acc[ai][bj][m][0][0]; a[1] = __uint_as_float(g.x & 0xffff0000u) * acc[ai][bj][m][0][1];
                    a[2] = __uint_as_float(g.y << 16) * acc[ai][bj][m][0][2]; a[3] = __uint_as_float(g.y & 0xffff0000u) * acc[ai][bj][m][0][3];
                    b[0] = __uint_as_float(g.z << 16) * acc[ai][bj][m][1][0]; b[1] = __uint_as_float(g.z & 0xffff0000u) * acc[ai][bj][m][1][1];
                    b[2] = __uint_as_float(g.w << 16) * acc[ai][bj][m][1][2]; b[3] = __uint_as_float(g.w & 0xffff0000u) * acc[ai][bj][m][1][3];
                    if (second) { const u32x4 p = *(const u32x4*)(merged + off);
                        a[0] += __uint_as_float(p.x << 16); a[1] += __uint_as_float(p.x & 0xffff0000u); a[2] += __uint_as_float(p.y << 16); a[3] += __uint_as_float(p.y & 0xffff0000u);
                        b[0] += __uint_as_float(p.z << 16); b[1] += __uint_as_float(p.z & 0xffff0000u); b[2] += __uint_as_float(p.w << 16); b[3] += __uint_as_float(p.w & 0xffff0000u); }
                    st16(merged + off, a, b);
                }
            }
    }
};
constexpr size_t MiB = 1u << 20;
constexpr size_t WS_SMALL = 0, WS_W = 2 * MiB, WS_SSQP = 50 * MiB, WS_CQS = 52 * MiB, WS_CKVS = 53 * MiB, WS_HB = 54 * MiB, WS_VTM = 54 * MiB, WS_KRAW = 86 * MiB,
                 WS_A = 118 * MiB, WS_SGA = 118 * MiB, WS_SGB = 182 * MiB, WS_KF = 246 * MiB, WS_CQ = 294 * MiB, WS_CKV = 326 * MiB, WS_QN = 342 * MiB, WS_KN = 374 * MiB,
                 WS_VTN = 406 * MiB, WS_QRAW = 438 * MiB, WS_END = 502 * MiB;
constexpr size_t SM_SSQM1 = 0, SM_SSQM2 = 256, SM_XMB = 1024, SM_ACTM = SM_XMB + 16 * 1024 * 2, SM_HM = SM_ACTM + 16 * 2816 * 2, SM_HMB = SM_HM + 16 * 1024 * 4, SM_PROJM = SM_HMB + 16 * 1024 * 2,
                 SM_PROJMB = SM_PROJM + 16 * 4352 * 4, SM_KVMK = SM_PROJMB + 16 * 4352 * 2, SM_KVMV = SM_KVMK + 16 * 512 * 4, SM_KFM = SM_KVMV + 16 * 512 * 4, SM_VTMM = SM_KFM + 8 * 64 * 96 * 2,
                 SM_KNM = SM_VTMM + 8 * 64 * 64 * 2, SM_VNMT = SM_KNM + 16 * 512 * 2, SM_END = SM_VNMT + 512 * 16 * 2;
static_assert(SM_END <= 1 * MiB, "small region");
constexpr size_t WS_BAR = 1 * MiB;
constexpr size_t W_GU1 = 0, W_D1 = W_GU1 + (size_t)5632 * 1024, W_IN = W_D1 + (size_t)1024 * 2816, W_INV = W_IN + (size_t)3840 * 1024, W_UQ = W_INV + (size_t)512 * 1024,
                 W_UK = W_UQ + (size_t)1024 * 384, W_UV = W_UK + (size_t)512 * 256, W_A = W_UV + (size_t)512 * 256, W_B = W_A + (size_t)1024 * 512, W_O = W_B + (size_t)1024 * 512,
                 W_GU2 = W_O + (size_t)1024 * 1024, W_D2 = W_GU2 + (size_t)5632 * 1024, W_ENDE = W_D2 + (size_t)1024 * 2816;
static_assert(W_ENDE * 2 <= 48 * MiB, "weights region");

__device__ __forceinline__ void tr_item(const float* W, int N, int K, const float* gain, bf16_t* WT, int dst_row0, int src_col0, int k0, LAS float* scr, int lane) {
    const int kr = lane >> 3, c4 = (lane & 7) * 4;
    f32x4 v[8];
#pragma unroll
    for (int i = 0; i < 8; ++i) { const int kk = 8 * i + kr; v[i] = (f32x4){0.f, 0.f, 0.f, 0.f};
        if (src_col0 >= 0) { v[i] = *(const f32x4*)(W + (size_t)(k0 + kk) * N + src_col0 + c4); if (gain) v[i] = v[i] * gain[k0 + kk]; } }
#pragma unroll
    for (int i = 0; i < 8; ++i) { LAS float* d = scr + (8 * i + kr) * 33 + c4; d[0] = v[i][0]; d[1] = v[i][1]; d[2] = v[i][2]; d[3] = v[i][3]; }
    asm volatile("s_waitcnt lgkmcnt(0)" ::: "memory");
    const int c = lane & 7;
#pragma unroll
    for (int j = 0; j < 4; ++j) { const int n = (lane >> 3) + 8 * j; const LAS float* s = scr + (8 * c) * 33 + n;
        u32x4 o; o.x = pk2(s[0 * 33], s[1 * 33]); o.y = pk2(s[2 * 33], s[3 * 33]); o.z = pk2(s[4 * 33], s[5 * 33]); o.w = pk2(s[6 * 33], s[7 * 33]);
        *(u32x4*)(WT + (size_t)(dst_row0 + n) * K + k0 + 8 * c) = o; }
    asm volatile("s_waitcnt lgkmcnt(0)" ::: "memory");
}
__device__ __forceinline__ float row_to_bf16(const float* xrow, bf16_t* orow, int lane) {
    const f32x4* xr = (const f32x4*)xrow + lane; f32x4 v[4]; float s = 0.f;
#pragma unroll
    for (int j = 0; j < 4; ++j) { v[j] = xr[64 * j]; s += sumsq4(v[j]); }
    const float tot = wave_sum(s), rr = __builtin_amdgcn_rsqf(tot * (1.f / 1024.f) + EPS);
    u32x2* o8 = (u32x2*)orow + lane;
#pragma unroll
    for (int j = 0; j < 4; ++j) { u32x2 w; w.x = pk2(v[j][0] * rr, v[j][1] * rr); w.y = pk2(v[j][2] * rr, v[j][3] * rr); o8[64 * j] = w; }
    return tot;
}
__device__ __forceinline__ void rows2_to_bf16(const float* x0, const float* x1, bf16_t* o0, bf16_t* o1, int lane, float& s0, float& s1) {
    const f32x4* a = (const f32x4*)x0 + lane; const f32x4* b = (const f32x4*)x1 + lane; f32x4 v[4], w[4];
#pragma unroll
    for (int j = 0; j < 4; ++j) { v[j] = a[64 * j]; w[j] = b[64 * j]; }
    float p = 0.f, q = 0.f;
#pragma unroll
    for (int j = 0; j < 4; ++j) { p += sumsq4(v[j]); q += sumsq4(w[j]); }
#pragma unroll
    for (int o = 1; o < 64; o <<= 1) { p += __shfl_xor(p, o); q += __shfl_xor(q, o); }
    s0 = p; s1 = q;
    const float r0 = __builtin_amdgcn_rsqf(p * (1.f / 1024.f) + EPS), r1 = __builtin_amdgcn_rsqf(q * (1.f / 1024.f) + EPS);
    u32x2* d0 = (u32x2*)o0 + lane; u32x2* d1 = (u32x2*)o1 + lane;
#pragma unroll
    for (int j = 0; j < 4; ++j) { u32x2 t; t.x = pk2(v[j][0] * r0, v[j][1] * r0); t.y = pk2(v[j][2] * r0, v[j][3] * r0); d0[64 * j] = t; t.x = pk2(w[j][0] * r1, w[j][1] * r1); t.y = pk2(w[j][2] * r1, w[j][3] * r1); d1[64 * j] = t; }
}
__device__ __forceinline__ f32x4 mfma16(bf16x8 a, bf16x8 b, f32x4 c) { return __builtin_amdgcn_mfma_f32_16x16x32_bf16(a, b, c, 0, 0, 0); }
__device__ __forceinline__ f32x16 mfma32(bf16x8 a, bf16x8 b, f32x16 c) { return __builtin_amdgcn_mfma_f32_32x32x16_bf16(a, b, c, 0, 0, 0); }
__device__ __forceinline__ void skinny_tile(const bf16_t* xp, const bf16_t* wp0, const bf16_t* wp1, int K, f32x4& a0, f32x4& a1) {
    a0 = (f32x4){0.f, 0.f, 0.f, 0.f}; a1 = a0;
#pragma unroll 4
    for (int k0 = 0; k0 < K; k0 += 32) {
        const bf16x8 x = *(const bf16x8*)(xp + k0); const bf16x8 w0 = *(const bf16x8*)(wp0 + k0); a0 = mfma16(w0, x, a0);
        if (wp1) { const bf16x8 w1 = *(const bf16x8*)(wp1 + k0); a1 = mfma16(w1, x, a1); }
    }
}
__device__ __forceinline__ void rope_cs(int pos, int i, float& c, float& s) {
    const float inv = exp2f(-(float)i * (13.287712379549449f / 16.f));
    const float ang = (float)pos * inv;
    double rev = (double)ang * 0.15915494309189535; rev -= __builtin_rint(rev);
    const float r = (float)rev; c = __builtin_amdgcn_cosf(r); s = __builtin_amdgcn_sinf(r);
}
__device__ __forceinline__ int crow(int r, int hi) { return (r & 3) + 8 * (r >> 2) + 4 * hi; }
__device__ __forceinline__ bf16x8 pack8(const f32x16& p, int base) {
    u32x4 w; w.x = pk2(p[base], p[base + 1]); w.y = pk2(p[base + 2], p[base + 3]); w.z = pk2(p[base + 4], p[base + 5]); w.w = pk2(p[base + 6], p[base + 7]); return __builtin_bit_cast(bf16x8, w);
}
__device__ __forceinline__ float max16(const f32x16& p) {
    float a = fmaxf(fmaxf(p[0], p[1]), fmaxf(p[2], p[3])), b = fmaxf(fmaxf(p[4], p[5]), fmaxf(p[6], p[7])), c = fmaxf(fmaxf(p[8], p[9]), fmaxf(p[10], p[11])), d = fmaxf(fmaxf(p[12], p[13]), fmaxf(p[14], p[15]));
    return fmaxf(fmaxf(a, b), fmaxf(c, d));
}
constexpr int MLA_KT = 12288, MLA_VT = 8192, MLA_BUF = MLA_KT + MLA_VT;
__device__ __forceinline__ int swap23(int k) { return (k & ~12) | ((k & 4) << 1) | ((k & 8) >> 1); }
__device__ __forceinline__ void mla_unit(const bool FIXED, LAS unsigned char* lds, int b, int h, int qb, const bf16_t* Qf, const bf16_t* Kf, const bf16_t* Kfm, const bf16_t* vT, const bf16_t* vTm, bf16_t* oa, int tid, int lane, int wid) {
    const int r32 = lane & 31, hi = lane >> 5;
    const size_t qrow = (size_t)b * TSEQ + qb * 256 + wid * 32 + r32;
    bf16x8 qr[6];
#pragma unroll
    for (int d0 = 0; d0 < 6; ++d0) qr[d0] = *(const bf16x8*)(Qf + qrow * 1024 + 128 * h + 16 * d0 + 8 * hi);
    const unsigned char* Ksrc = (const unsigned char*)Kf + ((size_t)(b * 8 + h) * 64) * MLA_KT + 16 * lane;
    const unsigned char* Kmsrc = (const unsigned char*)Kfm + (size_t)h * MLA_KT + 16 * lane;
    const int vd = 8 * wid + (lane >> 3), vg = (lane & 7) ^ ((vd >> 1) & 7);
    const bf16_t* Vsrc = vT + (size_t)(64 * h + vd) * M + (size_t)b * TSEQ + 8 * vg;
    const bf16_t* Vmsrc = vTm + (size_t)(64 * h + vd) * 64 + 8 * vg;
#define MLA_DMA(j, buf) do { LAS unsigned char* bp_ = lds + (buf) * MLA_BUF; const unsigned char* ks_ = (j) < 64 ? Ksrc + (size_t)(j) * MLA_KT : Kmsrc; const bf16_t* vs_ = (j) < 64 ? Vsrc + 64 * (j) : Vmsrc; \
        __builtin_amdgcn_global_load_lds((const unsigned*)(ks_ + 1024 * wid), (LAS unsigned*)(bp_ + 1024 * wid), 16, 0, 0); \
        if (wid < 4) __builtin_amdgcn_global_load_lds((const unsigned*)(ks_ + 1024 * (8 + wid)), (LAS unsigned*)(bp_ + 1024 * (8 + wid)), 16, 0, 0); \
        __builtin_amdgcn_global_load_lds((const unsigned*)vs_, (LAS unsigned*)(bp_ + MLA_KT + 1024 * wid), 16, 0, 0); } while (0)
    const int ksw = (r32 >> 2) & 3, vsw0 = (r32 >> 1) & 7;
    LAS unsigned char* const kbase0 = lds + r32 * 192 + 16 * (hi ^ ksw);
    LAS unsigned char* const kbase1 = lds + r32 * 192 + 16 * ((2 + hi) ^ ksw);
    LAS unsigned char* const vb0 = lds + 4 * MLA_KT + r32 * 128 + 16 * ((0 + hi) ^ vsw0);
    LAS unsigned char* const vb1 = lds + 4 * MLA_KT + r32 * 128 + 16 * ((2 + hi) ^ vsw0);
    LAS unsigned char* const vb2 = lds + 4 * MLA_KT + r32 * 128 + 16 * ((4 + hi) ^ vsw0);
    LAS unsigned char* const vb3 = lds + 4 * MLA_KT + r32 * 128 + 16 * ((6 + hi) ^ vsw0);
    float mrun = 0.f;
    f32x16 o0, o1, o2, sa, sb, zz;
#pragma unroll
    for (int i = 0; i < 16; ++i) { o0[i] = 0.f; o1[i] = 0.f; o2[i] = 0.f; zz[i] = 0.f; }
    const short one_ = (r32 == 0) ? (short)0x3F80 : (short)0; const bf16x8 onesf = {one_, one_, one_, one_, one_, one_, one_, one_};
#define KFRAG(slot, d0, half) (*(const LAS bf16x8*)(((d0) & 1 ? kbase1 : kbase0) + (slot) * MLA_KT + 64 * ((d0) >> 1) + 6144 * (half)))
#define VFRAG(slot, s_, db) (*(const LAS bf16x8*)(((s_) == 0 ? vb0 : (s_) == 1 ? vb1 : (s_) == 2 ? vb2 : vb3) + (slot) * MLA_VT + 4096 * (db)))
#define MLA_REF(first, S0, S1) do { _Pragma("unroll") for (int i = 0; i < 16; ++i) { S0[i] -= mrun; S1[i] -= mrun; } \
        float tm_ = fmaxf(max16(S0), max16(S1)); tm_ = fmaxf(tm_, __shfl_xor(tm_, 32)); \
        if ((first) || __any(tm_ > 8.f)) { const float dl_ = (first) ? tm_ : fmaxf(tm_, 0.f); mrun += dl_; const float al_ = __builtin_amdgcn_exp2f(-dl_); \
            _Pragma("unroll") for (int i = 0; i < 16; ++i) { S0[i] -= dl_; S1[i] -= dl_; o0[i] *= al_; o1[i] *= al_; o2[i] *= al_; } } } while (0)
#define SGB(mask, n) __builtin_amdgcn_sched_group_barrier(mask, n, 0)
#define MLA_BODY(J, PAR, HASNEXT, NEXTMETA) do { \
        f32x16 na, nb; bf16x8 kf[12], vf[8]; \
        if (HASNEXT) { _Pragma("unroll") for (int d0 = 0; d0 < 6; ++d0) { kf[2 * d0] = KFRAG(((PAR) + 1) % 4, d0, 0); kf[2 * d0 + 1] = KFRAG(((PAR) + 1) % 4, d0, 1); } } \
        if (HASNEXT) { na = mfma32(kf[0], qr[0], zz); nb = mfma32(kf[1], qr[0], zz); \
            _Pragma("unroll") for (int d0 = 1; d0 < 6; ++d0) { na = mfma32(kf[2 * d0], qr[d0], na); nb = mfma32(kf[2 * d0 + 1], qr[d0], nb); } } \
        _Pragma("unroll") for (int i = 0; i < 16; i += 2) { sa[i] = __builtin_amdgcn_exp2f(sa[i]); sa[i + 1] = __builtin_amdgcn_exp2f(sa[i + 1]); sb[i] = __builtin_amdgcn_exp2f(sb[i]); sb[i + 1] = __builtin_amdgcn_exp2f(sb[i + 1]); } \
        if (HASNEXT) { SGB(0x100, 12); _Pragma("unroll") for (int q_ = 0; q_ < 12; ++q_) { SGB(0x002, 5); SGB(0x008, 1); } } \
        __builtin_amdgcn_sched_barrier(0); \
        _Pragma("unroll") for (int s_ = 0; s_ < 4; ++s_) { vf[2 * s_] = VFRAG(PAR, s_, 0); vf[2 * s_ + 1] = VFRAG(PAR, s_, 1); } \
        { const bf16x8 pb0 = pack8(sa, 0), pb1 = pack8(sa, 8), pb2 = pack8(sb, 0), pb3 = pack8(sb, 8); \
          o0 = mfma32(vf[0], pb0, o0); o1 = mfma32(vf[1], pb0, o1); o2 = mfma32(onesf, pb0, o2); o0 = mfma32(vf[2], pb1, o0); o1 = mfma32(vf[3], pb1, o1); o2 = mfma32(onesf, pb1, o2); \
          o0 = mfma32(vf[4], pb2, o0); o1 = mfma32(vf[5], pb2, o1); o2 = mfma32(onesf, pb2, o2); o0 = mfma32(vf[6], pb3, o0); o1 = mfma32(vf[7], pb3, o1); o2 = mfma32(onesf, pb3, o2); } \
        SGB(0x100, 8); SGB(0x002, 4); _Pragma("unroll") for (int q_ = 0; q_ < 3; ++q_) { SGB(0x008, 3); SGB(0x002, 4); } SGB(0x008, 3); \
        if (HASNEXT) { if (NEXTMETA) { _Pragma("unroll") for (int i = 0; i < 16; ++i) { if (crow(i, hi) >= 16) na[i] = -INFINITY; nb[i] = -INFINITY; } } \
            if (!FIXED) MLA_REF(false, na, nb); sa = na; sb = nb; } \
        __builtin_amdgcn_sched_barrier(0); } while (0)
#define TILE_K(T, SLOT, KIND) do { if (KIND) { const unsigned char* ks_ = (KIND) == 1 ? Ksrc + (size_t)(T) * MLA_KT : Kmsrc; LAS unsigned char* kd_ = lds + (SLOT) * MLA_KT; \
        __builtin_amdgcn_global_load_lds((const unsigned*)(ks_ + 1024 * wid), (LAS unsigned*)(kd_ + 1024 * wid), 16, 0, 0); \
        if (wid < 4) __builtin_amdgcn_global_load_lds((const unsigned*)(ks_ + 1024 * k2piece), (LAS unsigned*)(kd_ + 1024 * k2piece), 16, 0, 0); } } while (0)
#define TILE_V(T, SLOT, KIND) do { if (KIND) { const bf16_t* vs_ = (KIND) == 1 ? Vsrc + 64 * (T) : Vmsrc; \
        __builtin_amdgcn_global_load_lds((const unsigned*)vs_, (LAS unsigned*)(lds + 4 * MLA_KT + (SLOT) * MLA_VT + 1024 * wid), 16, 0, 0); } } while (0)
#define PAIR_DMA(J, P4, K3, K4, V2, V3) do { TILE_K((J) + 3, ((P4) + 3) % 4, K3); TILE_V((J) + 2, ((P4) + 2) % 4, V2); TILE_K((J) + 4, (P4), K4); TILE_V((J) + 3, ((P4) + 3) % 4, V3); } while (0)
#define PAIR_END() do { asm volatile("s_waitcnt vmcnt(0)" ::: "memory"); __syncthreads(); __builtin_amdgcn_sched_barrier(0); } while (0)
    const int k2piece = wid < 4 ? 8 + wid : wid;
    {
#pragma unroll
        for (int t = 0; t < 3; ++t) { const unsigned char* ks_ = Ksrc + (size_t)t * MLA_KT; LAS unsigned char* kd_ = lds + t * MLA_KT;
            __builtin_amdgcn_global_load_lds((const unsigned*)(ks_ + 1024 * wid), (LAS unsigned*)(kd_ + 1024 * wid), 16, 0, 0);
            if (wid < 4) __builtin_amdgcn_global_load_lds((const unsigned*)(ks_ + 1024 * k2piece), (LAS unsigned*)(kd_ + 1024 * k2piece), 16, 0, 0); }
        __builtin_amdgcn_global_load_lds((const unsigned*)Vsrc, (LAS unsigned*)(lds + 4 * MLA_KT + 1024 * wid), 16, 0, 0);
        __builtin_amdgcn_global_load_lds((const unsigned*)(Vsrc + 64), (LAS unsigned*)(lds + 4 * MLA_KT + MLA_VT + 1024 * wid), 16, 0, 0);
    }
    asm volatile("s_waitcnt vmcnt(0)" ::: "memory"); __syncthreads();
    {
#pragma unroll
        for (int d0 = 0; d0 < 6; ++d0) { const bf16x8 ka_ = KFRAG(0, d0, 0), kb_ = KFRAG(0, d0, 1);
            if (d0 == 0) { sa = mfma32(ka_, qr[0], zz); sb = mfma32(kb_, qr[0], zz); } else { sa = mfma32(ka_, qr[d0], sa); sb = mfma32(kb_, qr[d0], sb); } }
        if (!FIXED) MLA_REF(true, sa, sb);
    }
    __syncthreads();
    for (int j = 0; j < 60; j += 4) {
        PAIR_DMA(j, 0, 1, 1, 1, 1);     MLA_BODY(j, 0, 1, 0);     MLA_BODY(j + 1, 1, 1, 0); PAIR_END();
        PAIR_DMA(j + 2, 2, 1, 1, 1, 1); MLA_BODY(j + 2, 2, 1, 0); MLA_BODY(j + 3, 3, 1, 0); PAIR_END(); }
    PAIR_DMA(60, 0, 1, 2, 1, 1); MLA_BODY(60, 0, 1, 0); MLA_BODY(61, 1, 1, 0); PAIR_END();
    PAIR_DMA(62, 2, 0, 0, 2, 0); MLA_BODY(62, 2, 1, 0); MLA_BODY(63, 3, 1, 1); PAIR_END();
    MLA_BODY(64, 0, 0, 0); __syncthreads();
#undef PAIR_DMA
#undef PAIR_END
#undef TILE_K
#undef TILE_V
#undef MLA_BODY
#undef MLA_REF
#undef KFRAG
#undef VFRAG
#undef SGB
#undef MLA_DMA
    const float lt = o2[0] + __shfl_xor(o2[0], 32), inv = 1.f / lt;
    bf16_t* orow = oa + qrow * 512 + 64 * h + 4 * hi;
#pragma unroll
    for (int g = 0; g < 4; ++g) {
        u32x2 w0, w1; w0.x = pk2(o0[4 * g] * inv, o0[4 * g + 1] * inv); w0.y = pk2(o0[4 * g + 2] * inv, o0[4 * g + 3] * inv);
        w1.x = pk2(o1[4 * g] * inv, o1[4 * g + 1] * inv); w1.y = pk2(o1[4 * g + 2] * inv, o1[4 * g + 3] * inv);
        *(u32x2*)(orow + 8 * g) = w0; *(u32x2*)(orow + 32 + 8 * g) = w1;
    }
}
constexpr int NA_BIAS_OFF = 131072 + 256;
#define NA_LOAD(KB, KF, VF) do { if ((KB) < 0) { \
            _Pragma("unroll") for (int d0 = 0; d0 < 4; ++d0) { u32x4 z = {0u, 0u, 0u, 0u}; if (r32 < 16) z = *(const u32x4*)(knm + swap23(r32) * 512 + 64 * h + 16 * d0 + 8 * hi); KF[d0] = __builtin_bit_cast(bf16x8, z); } \
            _Pragma("unroll") for (int db = 0; db < 2; ++db) { VF[0][db] = *(const bf16x8*)(vnmT + (size_t)(64 * h + 32 * db + r32) * 16 + 8 * hi); VF[1][db] = __builtin_bit_cast(bf16x8, (u32x4){0u, 0u, 0u, 0u}); } \
        } else { const size_t ktok = (size_t)b * TSEQ + 64 * (rs + ((KB) >> 1)) + 32 * ((KB) & 1); \
            _Pragma("unroll") for (int d0 = 0; d0 < 4; ++d0) KF[d0] = *(const bf16x8*)(kn + (ktok + swap23(r32)) * 512 + 64 * h + 16 * d0 + 8 * hi); \
            _Pragma("unroll") for (int s = 0; s < 2; ++s) _Pragma("unroll") for (int db = 0; db < 2; ++db) VF[s][db] = *(const bf16x8*)(vTn + (size_t)(64 * h + 32 * db + r32) * M + ktok + 16 * s + 8 * hi); } } while (0)
template <bool FIXED> __device__ __forceinline__ void na_unit(LAS unsigned char* lds, LAS unsigned char* wl, int b, int h, int r, const bf16_t* qn, const bf16_t* kn, const bf16_t* vTn, const bf16_t* knm, const bf16_t* vnmT, bf16_t* ob, int lane) {
    const int r32 = lane & 31, hi = lane >> 5;
    const size_t tok0 = (size_t)b * TSEQ + 64 * r;
    bf16x8 qr[2][4];
#pragma unroll
    for (int qb = 0; qb < 2; ++qb)
#pragma unroll
        for (int d0 = 0; d0 < 4; ++d0) qr[qb][d0] = *(const bf16x8*)(qn + (tok0 + 32 * qb + r32) * 512 + 64 * h + 16 * d0 + 8 * hi);
    int rs = r - 4; rs = rs < 0 ? 0 : (rs > 56 ? 56 : rs);
    float mrun[2] = {0.f, 0.f}, lrun[2] = {0.f, 0.f};
    f32x16 o[2][2];
#pragma unroll
    for (int a = 0; a < 2; ++a)
#pragma unroll
        for (int c = 0; c < 2; ++c)
#pragma unroll
            for (int i = 0; i < 16; ++i) o[a][c][i] = 0.f;
    const LAS float* bt = (const LAS float*)(lds + NA_BIAS_OFF) + h * 465 + (rs - r + 7) * 31;
    const int r3 = lane >> 3;
    const bf16_t* ksrc = kn + ((size_t)b * TSEQ + 64 * rs) * 512 + 64 * h + (size_t)((r3 & 3) + 8 * ((r3 >> 2) & 1)) * 512;
    const int kp0 = 8 * ((lane & 7) ^ (r3 >> 1)), kp1 = 8 * ((lane & 7) ^ (4 + (r3 >> 1)));
    const bf16_t* vsrc = vTn + (size_t)(64 * h + (lane >> 2)) * M + (size_t)b * TSEQ + 64 * rs + 8 * ((lane & 3) ^ ((lane >> 4) & 3));
#define NA_DMA(KB, BUF) do { const int to_ = 64 * ((KB) >> 1) + 32 * ((KB) & 1); LAS unsigned char* kd_ = wl + (BUF) * 8192; \
        _Pragma("unroll") for (int n = 0; n < 4; ++n) __builtin_amdgcn_global_load_lds((const unsigned*)(ksrc + (size_t)(to_ + 4 * (n & 1) + 16 * (n >> 1)) * 512 + ((n & 1) ? kp1 : kp0)), (LAS unsigned*)(kd_ + 1024 * n), 16, 0, 0); \
        _Pragma("unroll") for (int n = 0; n < 4; ++n) __builtin_amdgcn_global_load_lds((const unsigned*)(vsrc + (size_t)(16 * n) * M + to_), (LAS unsigned*)(kd_ + 4096 + 1024 * n), 16, 0, 0); } while (0)
    const int ksw = (r32 >> 1) & 7, vsw = (r32 >> 2) & 3;
    bf16x8 kf[4], vf[2][2];
    NA_LOAD(-1, kf, vf);
    NA_DMA(0, 0);
#define NA_QB(QB, I0, I1, IS_META, KB, KCBC) do { f32x16 p; \
        _Pragma("unroll") for (int i = 0; i < 16; ++i) p[i] = 0.f; \
        _Pragma("unroll") for (int d0 = 0; d0 < 4; ++d0) p = mfma32(kf[d0], qr[QB][d0], p); \
        if (IS_META) { _Pragma("unroll") for (int i = 0; i < 16; ++i) if (crow(i, hi) >= 16) p[i] = -INFINITY; } \
        else { const int c = 32 * (QB) + r32; int cs = c - 8; cs = cs < 0 ? 0 : (cs > 48 ? 48 : cs); \
            const int krel = 32 * (KCBC) + 8 * hi - cs; const LAS float* brow = bt + 31 * ((KB) >> 1) + (32 * (KCBC) + 8 * hi - c + 15); \
            _Pragma("unroll") for (int i = (I0); i < (I1); ++i) { const int off = (i & 3) + 4 * ((i >> 2) & 1) + 16 * (i >> 3); const bool ok = (unsigned)(krel + off) < 16u; \
                const float pv = p[i] + brow[off]; p[i] = ok ? pv : -INFINITY; } } \
        if constexpr (!FIXED) { float tm = -INFINITY; _Pragma("unroll") for (int i = (I0); i < (I1); ++i) tm = fmaxf(tm, p[i]); tm = fmaxf(tm, __shfl_xor(tm, 32)); \
            if ((IS_META) || __any(tm - mrun[QB] > 8.f)) { const float mnew = (IS_META) ? tm : fmaxf(mrun[QB], tm), alpha = __builtin_amdgcn_exp2f(mrun[QB] - mnew); mrun[QB] = mnew; lrun[QB] *= alpha; \
                _Pragma("unroll") for (int i = 0; i < 16; ++i) { o[QB][0][i] *= alpha; o[QB][1][i] *= alpha; } } } \
        float ls0 = 0.f, ls1 = 0.f; const float mr = FIXED ? 0.f : mrun[QB]; \
        _Pragma("unroll") for (int i = (I0); i < (I1); i += 2) { p[i] = __builtin_amdgcn_exp2f(p[i] - mr); p[i + 1] = __builtin_amdgcn_exp2f(p[i + 1] - mr); ls0 += p[i]; ls1 += p[i + 1]; } \
        lrun[QB] += ls0 + ls1; \
        if ((I0) == 0) { const bf16x8 pb0 = pack8(p, 0); o[QB][0] = mfma32(vf[0][0], pb0, o[QB][0]); o[QB][1] = mfma32(vf[0][1], pb0, o[QB][1]); } \
        if ((I1) == 16 && !(IS_META)) { const bf16x8 pb1 = pack8(p, 8); o[QB][0] = mfma32(vf[1][0], pb1, o[QB][0]); o[QB][1] = mfma32(vf[1][1], pb1, o[QB][1]); } } while (0)
#define NA_FETCH(KB) do { asm volatile("s_waitcnt vmcnt(0)" ::: "memory"); \
        const LAS unsigned char* bp = wl + ((KB) & 1) * 8192; \
        _Pragma("unroll") for (int d0 = 0; d0 < 4; ++d0) kf[d0] = *(const LAS bf16x8*)(bp + r32 * 128 + 16 * ((2 * d0 + hi) ^ ksw)); \
        _Pragma("unroll") for (int s = 0; s < 2; ++s) _Pragma("unroll") for (int db = 0; db < 2; ++db) vf[s][db] = *(const LAS bf16x8*)(bp + 4096 + (32 * db + r32) * 64 + 16 * ((2 * s + hi) ^ vsw)); \
        if ((KB) + 1 < 16) NA_DMA((KB) + 1, ((KB) + 1) & 1); } while (0)
    NA_QB(0, 0, 16, 1, -1, 0); NA_QB(1, 0, 16, 1, -1, 0);
    for (int kb = 0; kb < 16; kb += 2) {
        NA_FETCH(kb);     NA_QB(0, 0, 16, 0, kb, 0);     NA_QB(1, 8, 16, 0, kb, 0);
        NA_FETCH(kb + 1); NA_QB(0, 0, 8, 0, kb + 1, 1);  NA_QB(1, 0, 16, 0, kb + 1, 1);
    }
#undef NA_QB
#undef NA_FETCH
#pragma unroll
    for (int qb = 0; qb < 2; ++qb) {
        const float lt = lrun[qb] + __shfl_xor(lrun[qb], 32), inv = 1.f / lt;
        bf16_t* orow = ob + (tok0 + 32 * qb + r32) * 512 + 64 * h + 4 * hi;
#pragma unroll
        for (int g = 0; g < 4; ++g) {
            u32x2 w0, w1; w0.x = pk2(o[qb][0][4 * g] * inv, o[qb][0][4 * g + 1] * inv); w0.y = pk2(o[qb][0][4 * g + 2] * inv, o[qb][0][4 * g + 3] * inv);
            w1.x = pk2(o[qb][1][4 * g] * inv, o[qb][1][4 * g + 1] * inv); w1.y = pk2(o[qb][1][4 * g + 2] * inv, o[qb][1][4 * g + 3] * inv);
            *(u32x2*)(orow + 8 * g) = w0; *(u32x2*)(orow + 32 + 8 * g) = w1;
        }
    }
}
#undef NA_LOAD
#undef NA_DMA
#define XB_TMO      128
#define XB_XCNT(j)  (256  + 64 * (j))
#define XB_XSUB(j)  (1280 + 64 * (j))
#define XB_XGEN(j)  (2304 + 64 * (j))
#define XB_TOP      3328
#define XB_TOPGEN   3392
#define XCD_BAR_WORDS 3456
#define XB_SPIN_CAP (1u << 18)

__device__ __forceinline__ unsigned xb_ld(unsigned* p)              { return __hip_atomic_load(p, __ATOMIC_RELAXED, __HIP_MEMORY_SCOPE_AGENT); }
__device__ __forceinline__ unsigned xb_add(unsigned* p, unsigned v) { return __hip_atomic_fetch_add(p, v, __ATOMIC_RELAXED, __HIP_MEMORY_SCOPE_AGENT); }
__device__ __forceinline__ unsigned xb_xcc_id() { return (unsigned)__builtin_amdgcn_s_getreg((3 << 11) | 20) & 0xFu; }
#define XB_SPIN(cond, bar) do { unsigned _sp = 0; while (cond) { __builtin_amdgcn_s_sleep(1); \
    if ((++_sp & 255u) == 0u) { if (xb_ld(&(bar)[XB_TMO])) break; if (_sp > XB_SPIN_CAP) { atomicAdd(&(bar)[XB_TMO], 1u); break; } } } } while (0)

struct XcdBarrier {
    unsigned* bar; unsigned x;
    volatile LAS unsigned* st;
};

__device__ __forceinline__ XcdBarrier xcd_barrier_post(unsigned* bar, volatile LAS unsigned* st) {
    XcdBarrier b; b.bar = bar; b.x = (unsigned)__builtin_amdgcn_readfirstlane((int)xb_xcc_id()); b.st = st;
    if (threadIdx.x == 0) (void)xb_add(&bar[XB_XCNT(b.x)], 1u);
    return b;
}
__device__ __forceinline__ void xcd_barrier_complete(unsigned* bar, unsigned x, unsigned& nloc, unsigned& nx) {
    const unsigned G = gridDim.x * gridDim.y * gridDim.z;
    unsigned sum, cnt, mine, sp = 0u;
    for (;;) {
        sum = 0u; cnt = 0u; mine = 0u;
#pragma unroll
        for (unsigned j = 0; j < 16; ++j) { const unsigned c = xb_ld(&bar[XB_XCNT(j)]); sum += c; cnt += (c > 0u) ? 1u : 0u; mine = (j == x) ? c : mine; }
        if (sum == G) break;
        __builtin_amdgcn_s_sleep(1);
        if ((++sp & 255u) == 0u) { if (xb_ld(&bar[XB_TMO])) break; if (sp > XB_SPIN_CAP) { atomicAdd(&bar[XB_TMO], 1u); break; } }
    }
    nloc = mine > 0u ? mine : 1u; nx = cnt > 0u ? cnt : 1u;
}

__device__ __forceinline__ void xcd_barrier(const XcdBarrier& b) {
    asm volatile("s_waitcnt vmcnt(0)" ::: "memory");
    __syncthreads();
    if (threadIdx.x == 0) {
        unsigned* bar = b.bar;
        __builtin_amdgcn_s_waitcnt(0);
        unsigned nloc = b.st[0], nx = b.st[1];
        if (nloc == 0u) { xcd_barrier_complete(bar, b.x, nloc, nx); b.st[0] = nloc; b.st[1] = nx; }
        const unsigned old = xb_add(&bar[XB_XSUB(b.x)], 1u);
        const unsigned gen = old / nloc;
        if (old + 1u == (gen + 1u) * nloc) {
            __builtin_amdgcn_fence(__ATOMIC_RELEASE, "agent");
            asm volatile("s_waitcnt vmcnt(0)" ::: "memory");
            const unsigned og = xb_add(&bar[XB_TOP], 1u);
            const unsigned tg = og / nx;
            if (og + 1u == (tg + 1u) * nx) xb_add(&bar[XB_TOPGEN], 1u);
            else XB_SPIN(xb_ld(&bar[XB_TOPGEN]) == tg, bar);
            __builtin_amdgcn_fence(__ATOMIC_ACQUIRE, "agent");
            xb_add(&bar[XB_XGEN(b.x)], 1u);
            asm volatile("s_waitcnt vmcnt(0)" ::: "memory");
        } else {
            XB_SPIN(xb_ld(&bar[XB_XGEN(b.x)]) == gen, bar);
            __builtin_amdgcn_fence(__ATOMIC_ACQUIRE, "agent");
            asm volatile("s_waitcnt vmcnt(0)" ::: "memory");
        }
    }
    __syncthreads();
}

struct Args { const float* in[24]; float* out; unsigned char* ws; };
constexpr int LDS_BYTES = 147456;
#define GSYNC() do { XcdBarrier b_ = xbar; unsigned zo_ = 0u; asm volatile("" : "+s"(zo_)); b_.bar = b_.bar + zo_; unsigned xo_ = b_.x; asm volatile("" : "+s"(xo_)); b_.x = xo_; xcd_barrier(b_); } while (0)
#ifndef GEMM_MASK
#define GEMM_MASK 0xffff
#endif

__global__ void __launch_bounds__(512, 2) mega_fwd(Args args) {
    extern __shared__ __attribute__((aligned(16))) unsigned char lds_raw[];
    LAS unsigned char* lds = (LAS unsigned char*)lds_raw;
    cg::grid_group grid = cg::this_grid();
    float* const out = args.out; const float* const x = args.in[0];
    volatile LAS unsigned* MISC = (volatile LAS unsigned*)(lds + 147392);
    if (threadIdx.x < 4) MISC[threadIdx.x] = 0u;
    __syncthreads();
    XcdBarrier xbar; xbar.bar = (unsigned*)(args.ws + WS_BAR); xbar.x = 0; xbar.st = MISC;
#define PH_BEGIN int tid = threadIdx.x; asm volatile("" : "+v"(tid)); unsigned zoff_ = 0u; asm volatile("" : "+s"(zoff_)); unsigned char* ws = args.ws + zoff_; \
    const int lane = tid & 63, wave = __builtin_amdgcn_readfirstlane(tid >> 6), r16 = lane & 15, q4 = lane >> 4; \
    const int G = gridDim.x, bx = blockIdx.x; const int gw = bx * 8 + wave, NGW = G * 8; (void)r16; (void)q4; (void)gw; (void)NGW; (void)lane;
#define Wb ((bf16_t*)(ws + WS_W))
#define HB ((bf16_t*)(ws + WS_HB))
#define ACT ((bf16_t*)(ws + WS_A))
#define ssqp ((float*)(ws + WS_SSQP))
#define cqs ((float*)(ws + WS_CQS))
#define ckvs ((float*)(ws + WS_CKVS))
#define CQ ((bf16_t*)(ws + WS_CQ))
#define CKV ((bf16_t*)(ws + WS_CKV))
#define QN ((bf16_t*)(ws + WS_QN))
#define KN ((bf16_t*)(ws + WS_KN))
#define SGA ((bf16_t*)(ws + WS_SGA))
#define SGB ((bf16_t*)(ws + WS_SGB))
#define VTN ((bf16_t*)(ws + WS_VTN))
#define QRAW ((bf16_t*)(ws + WS_QRAW))
#define KRAW ((bf16_t*)(ws + WS_KRAW))
#define VTM ((bf16_t*)(ws + WS_VTM))
#define KF ((bf16_t*)(ws + WS_KF))
#define OA CQ
#define OB KRAW
#define MERGED QRAW
#define sm (ws + WS_SMALL)
#define ssqm1 ((float*)(sm + SM_SSQM1))
#define ssqm2 ((float*)(sm + SM_SSQM2))
#define xmb ((bf16_t*)(sm + SM_XMB))
#define actm ((bf16_t*)(sm + SM_ACTM))
#define hm ((float*)(sm + SM_HM))
#define hmb ((bf16_t*)(sm + SM_HMB))
#define projm ((float*)(sm + SM_PROJM))
#define projmb ((bf16_t*)(sm + SM_PROJMB))
#define kvmk ((float*)(sm + SM_KVMK))
#define kvmv ((float*)(sm + SM_KVMV))
#define kfm ((bf16_t*)(sm + SM_KFM))
#define vtmm ((bf16_t*)(sm + SM_VTMM))
#define knm ((bf16_t*)(sm + SM_KNM))
#define vnmT ((bf16_t*)(sm + SM_VNMT))

    { PH_BEGIN
        LAS float* scr = (LAS float*)(lds + wave * 16384);
        constexpr int I_GU = 16 * 176, I_D = 44 * 32, I_IN = 16 * 120, I_INV = 16 * 16, I_UQ = 6 * 32, I_UK = 4 * 16, I_AB = 8 * 32, I_O = 16 * 32;
        constexpr int NITEMS = 2 * I_GU + 2 * I_D + I_IN + I_INV + I_UQ + 2 * I_UK + 2 * I_AB + I_O;
        for (int it = gw; it < NITEMS; it += NGW) {
            int r = it;
            { const bool late_ = (it >= I_GU && it < 2 * I_GU) || (it >= 2 * I_GU + I_D && it < 2 * I_GU + 2 * I_D) || it >= 2 * I_GU + 2 * I_D + I_IN + I_INV + I_UQ + 2 * I_UK; if (late_) continue; }
            if (r < 2 * I_GU) { const int l2 = r >= I_GU; if (l2) r -= I_GU; const int kb = r / 176, nb = r % 176, n0 = 32 * nb, tile = n0 >> 8, half = (n0 >> 7) & 1, j = n0 & 127;
                const float* W = args.in[(l2 ? 21 : 3) + half]; tr_item(W, FF, 1024, args.in[l2 ? 20 : 2], Wb + (l2 ? W_GU2 : W_GU1), n0, 128 * tile + j, 64 * kb, scr, lane); continue; }
            r -= 2 * I_GU;
            if (r < 2 * I_D) { const int l2 = r >= I_D; if (l2) r -= I_D; const int kb = r / 32, nb = r % 32;
                tr_item(args.in[l2 ? 23 : 5], 1024, FF, nullptr, Wb + (l2 ? W_D2 : W_D1), 32 * nb, 32 * nb, 64 * kb, scr, lane); continue; }
            r -= 2 * I_D;
            if (r < I_IN) { const int kb = r / 120, nb = r % 120, n0 = 32 * nb; int src;
                if (n0 < 384) src = n0; else if (n0 < 416) src = 640 + (n0 - 384); else if (n0 < 512) src = -1; else if (n0 < 768) src = 384 + (n0 - 512);
                else if (n0 < 1792) { const bool isq = n0 < 1280; const int c = n0 - (isq ? 768 : 1280), t = c >> 8, cc = c & 255, bj = cc >> 7, wc = (cc & 127) >> 5; src = (isq ? 672 : 1184) + 64 * (4 * t + wc) + 32 * bj; }
                else if (n0 < 2816) src = 2208 + (n0 - 1792); else src = 3232 + (n0 - 2816);
                tr_item(args.in[7], 4256, 1024, args.in[6], Wb + W_IN, n0, src, 64 * kb, scr, lane); continue; }
            r -= I_IN;
            if (r < I_INV) { const int kb = r / 16, nb = r % 16; tr_item(args.in[7], 4256, 1024, args.in[6], Wb + W_INV, 32 * nb, 1696 + 32 * nb, 64 * kb, scr, lane); continue; }
            r -= I_INV;
            if (r < I_UQ) { const int kb = r / 32, nb = r % 32, n0 = 32 * nb, hh = n0 >> 7, j = n0 & 127; tr_item(args.in[9], 768, 384, args.in[8], Wb + W_UQ, n0, j < 96 ? 96 * hh + j : -1, 64 * kb, scr, lane); continue; }
            r -= I_UQ;
            if (r < 2 * I_UK) { const int isv = r >= I_UK; if (isv) r -= I_UK; const int kb = r / 16, nb = r % 16, n0 = 32 * nb, hh = n0 >> 6, j = n0 & 63;
                tr_item(args.in[11], 1024, 256, args.in[10], Wb + (isv ? W_UV : W_UK), n0, 128 * hh + (isv ? 64 : 0) + j, 64 * kb, scr, lane); continue; }
            r -= 2 * I_UK;
            if (r < 2 * I_AB) { const int isb = r >= I_AB; if (isb) r -= I_AB; const int kb = r / 32, nb = r % 32; tr_item(args.in[isb ? 18 : 17], 1024, 512, nullptr, Wb + (isb ? W_B : W_A), 32 * nb, 32 * nb, 64 * kb, scr, lane); continue; }
            r -= 2 * I_AB;
            { const int kb = r / 32, nb = r % 32; tr_item(args.in[19], 1024, 1024, nullptr, Wb + W_O, 32 * nb, 32 * nb, 64 * kb, scr, lane); }
        }
        for (int m = gw; m < M; m += 2 * NGW) {
            const int m1 = m + NGW; float s0, s1;
            if (m1 >= M) { s0 = row_to_bf16(x + (size_t)m * DM, HB + (size_t)m * DM, lane); if (lane < 16) ssqp[(size_t)m * 16 + lane] = lane == 0 ? s0 : 0.f; continue; }
            rows2_to_bf16(x + (size_t)m * DM, x + (size_t)m1 * DM, HB + (size_t)m * DM, HB + (size_t)m1 * DM, lane, s0, s1);
            if (lane < 16) { ssqp[(size_t)m * 16 + lane] = lane == 0 ? s0 : 0.f; ssqp[(size_t)m1 * 16 + lane] = lane == 0 ? s1 : 0.f; } }
        if (gw < 16) { const float s = row_to_bf16(args.in[1] + (size_t)gw * DM, xmb + (size_t)gw * DM, lane); if (lane == 0) ssqm1[gw] = s; }
        { const int gt = bx * 512 + tid, NGT = G * 512;
          if (gt < 16) ssqm2[gt] = 0.f;
          for (int i = gt; i < (8 * 64 * 96) / 8; i += NGT) ((u32x4*)kfm)[i] = (u32x4){0u, 0u, 0u, 0u};
          for (int i = gt; i < (8 * 64 * 64) / 8; i += NGT) ((u32x4*)vtmm)[i] = (u32x4){0u, 0u, 0u, 0u}; }
    }
#ifdef PROBE_P02
    GSYNC();
    { PH_BEGIN
        LAS float* scr = (LAS float*)(lds + wave * 16384);
        constexpr int I_GU = 16 * 176, I_D = 44 * 32, I_IN = 16 * 120, I_INV = 16 * 16, I_UQ = 6 * 32, I_UK = 4 * 16, I_AB = 8 * 32, I_O = 16 * 32;
        constexpr int NITEMS = 2 * I_GU + 2 * I_D + I_IN + I_INV + I_UQ + 2 * I_UK + 2 * I_AB + I_O;
        for (int it = gw; it < NITEMS; it += NGW) {
            int r = it;
            if (r < 2 * I_GU) { const int l2 = r >= I_GU; if (l2) r -= I_GU; const int kb = r / 176, nb = r % 176, n0 = 32 * nb, tile = n0 >> 8, half = (n0 >> 7) & 1, j = n0 & 127;
                const float* W = args.in[(l2 ? 21 : 3) + half]; tr_item(W, FF, 1024, args.in[l2 ? 20 : 2], Wb + (l2 ? W_GU2 : W_GU1), n0, 128 * tile + j, 64 * kb, scr, lane); continue; }
            r -= 2 * I_GU;
            if (r < 2 * I_D) { const int l2 = r >= I_D; if (l2) r -= I_D; const int kb = r / 32, nb = r % 32;
                tr_item(args.in[l2 ? 23 : 5], 1024, FF, nullptr, Wb + (l2 ? W_D2 : W_D1), 32 * nb, 32 * nb, 64 * kb, scr, lane); continue; }
            r -= 2 * I_D;
            if (r < I_IN) { const int kb = r / 120, nb = r % 120, n0 = 32 * nb; int src;
                if (n0 < 384) src = n0; else if (n0 < 416) src = 640 + (n0 - 384); else if (n0 < 512) src = -1; else if (n0 < 768) src = 384 + (n0 - 512);
                else if (n0 < 1792) { const bool isq = n0 < 1280; const int c = n0 - (isq ? 768 : 1280), t = c >> 8, cc = c & 255, bj = cc >> 7, wc = (cc & 127) >> 5; src = (isq ? 672 : 1184) + 64 * (4 * t + wc) + 32 * bj; }
                else if (n0 < 2816) src = 2208 + (n0 - 1792); else src = 3232 + (n0 - 2816);
                tr_item(args.in[7], 4256, 1024, args.in[6], Wb + W_IN, n0, src, 64 * kb, scr, lane); continue; }
            r -= I_IN;
            if (r < I_INV) { const int kb = r / 16, nb = r % 16; tr_item(args.in[7], 4256, 1024, args.in[6], Wb + W_INV, 32 * nb, 1696 + 32 * nb, 64 * kb, scr, lane); continue; }
            r -= I_INV;
            if (r < I_UQ) { const int kb = r / 32, nb = r % 32, n0 = 32 * nb, hh = n0 >> 7, j = n0 & 127; tr_item(args.in[9], 768, 384, args.in[8], Wb + W_UQ, n0, j < 96 ? 96 * hh + j : -1, 64 * kb, scr, lane); continue; }
            r -= I_UQ;
            if (r < 2 * I_UK) { const int isv = r >= I_UK; if (isv) r -= I_UK; const int kb = r / 16, nb = r % 16, n0 = 32 * nb, hh = n0 >> 6, j = n0 & 63;
                tr_item(args.in[11], 1024, 256, args.in[10], Wb + (isv ? W_UV : W_UK), n0, 128 * hh + (isv ? 64 : 0) + j, 64 * kb, scr, lane); continue; }
            r -= 2 * I_UK;
            if (r < 2 * I_AB) { const int isb = r >= I_AB; if (isb) r -= I_AB; const int kb = r / 32, nb = r % 32; tr_item(args.in[isb ? 18 : 17], 1024, 512, nullptr, Wb + (isb ? W_B : W_A), 32 * nb, 32 * nb, 64 * kb, scr, lane); continue; }
            r -= 2 * I_AB;
            { const int kb = r / 32, nb = r % 32; tr_item(args.in[19], 1024, 1024, nullptr, Wb + W_O, 32 * nb, 32 * nb, 64 * kb, scr, lane); }
        }
        for (int m = gw; m < M + 16; m += NGW) {
            if (m < M) { const float s = row_to_bf16(x + (size_t)m * DM, HB + (size_t)m * DM, lane); if (lane < 16) ssqp[(size_t)m * 16 + lane] = lane == 0 ? s : 0.f; }
            else { const int mm = m - M; const float s = row_to_bf16(args.in[1] + (size_t)mm * DM, xmb + (size_t)mm * DM, lane); if (lane == 0) ssqm1[mm] = s; }
        }
        { const int gt = bx * 512 + tid, NGT = G * 512;
          if (gt < 16) ssqm2[gt] = 0.f;
          for (int i = gt; i < (8 * 64 * 96) / 8; i += NGT) ((u32x4*)kfm)[i] = (u32x4){0u, 0u, 0u, 0u};
          for (int i = gt; i < (8 * 64 * 64) / 8; i += NGT) ((u32x4*)vtmm)[i] = (u32x4){0u, 0u, 0u, 0u}; }
    }
#endif
    if (args.ws == nullptr) grid.sync();
    xbar = xcd_barrier_post((unsigned*)(args.ws + WS_BAR), MISC);
    GSYNC();
#ifdef PROBE_SYNC10
    GSYNC(); GSYNC(); GSYNC(); GSYNC(); GSYNC(); GSYNC(); GSYNC(); GSYNC(); GSYNC(); GSYNC();
#endif

#define META_REDUCE1(A0) { LAS f32x4* red_ = (LAS f32x4*)lds; red_[wave * 64 + lane] = A0; __syncthreads(); \
            if (wave == 0) { A0 = red_[lane]; _Pragma("unroll") for (int w_ = 1; w_ < 8; ++w_) A0 += red_[w_ * 64 + lane]; } }
#define META_REDUCE(A0, A1) { LAS f32x4* red_ = (LAS f32x4*)lds; red_[(wave * 2 + 0) * 64 + lane] = A0; red_[(wave * 2 + 1) * 64 + lane] = A1; __syncthreads(); \
            if (wave == 0) { A0 = red_[lane]; A1 = red_[64 + lane]; _Pragma("unroll") for (int w_ = 1; w_ < 8; ++w_) { A0 += red_[(w_ * 2) * 64 + lane]; A1 += red_[(w_ * 2 + 1) * 64 + lane]; } } }
#pragma unroll
    for (int rep = 0; rep < 2; ++rep) {
        { PH_BEGIN
        if (rep == 0) {
            for (int task = bx; task < 176; task += G) { const int a0 = 16 * task, tile = a0 >> 7, j = a0 & 127, n0 = 256 * tile + j;
                f32x4 g, u; const bf16_t* wp = Wb + W_GU1 + (size_t)(n0 + r16) * 1024 + 8 * q4 + 128 * wave; skinny_tile(xmb + r16 * 1024 + 8 * q4 + 128 * wave, wp, wp + 128 * 1024, 128, g, u);
                META_REDUCE(g, u)
                if (wave == 0) {
                const float rs = 1.f;
                u32x2 w; w.x = pk2(silu_f(g[0] * rs) * (u[0] * rs), silu_f(g[1] * rs) * (u[1] * rs)); w.y = pk2(silu_f(g[2] * rs) * (u[2] * rs), silu_f(g[3] * rs) * (u[3] * rs));
                *(u32x2*)(actm + r16 * FF + a0 + 4 * q4) = w; }
                __syncthreads(); }
        }
#if (GEMM_MASK >> 0) & 1
        { pg8::Gemm g{HB, Wb + (rep ? W_GU2 : W_GU1), 1024, 1024, 1024}; pg8::StaticOrder S; S.init(M / 256, 22, G, bx); EpiSwiGLU E{ACT, rep ? ssqp : nullptr, lds, -1};
          pg8::gemm_phase<EpiSwiGLU, pg8::StaticOrder, true, true>(lds, g, S, E); }
#ifdef PROBE_GU2
        if (rep == 0) { pg8::Gemm g{HB, Wb + (rep ? W_GU2 : W_GU1), 1024, 1024, 1024}; pg8::StaticOrder S; S.init(M / 256, 22, G, bx); EpiSwiGLU E{ACT, rep ? ssqp : nullptr, lds, -1};
          pg8::gemm_phase<EpiSwiGLU, pg8::StaticOrder, true, true>(lds, g, S, E); }
#endif
#endif
        }
        GSYNC();
        { PH_BEGIN
        if (rep == 0) {
            for (int task = bx; task < 64; task += G) { const int n0 = 16 * task; f32x4 a, dmy; skinny_tile(actm + r16 * FF + 8 * q4 + 352 * wave, Wb + W_D1 + (size_t)(n0 + r16) * FF + 8 * q4 + 352 * wave, nullptr, 352, a, dmy);
                META_REDUCE1(a)
                if (wave == 0) {
                const size_t off = (size_t)r16 * 1024 + n0 + 4 * q4; const f32x4 v = *(const f32x4*)(args.in[1] + off) + 0.5f * a; *(f32x4*)(hm + off) = v;
                u32x2 w; w.x = pk2(v[0], v[1]); w.y = pk2(v[2], v[3]); *(u32x2*)(hmb + off) = w;
                float s = sumsq4(v); s += __shfl_xor(s, 16); s += __shfl_xor(s, 32); if (q4 == 0) atomicAdd(ssqm2 + r16, s); }
                __syncthreads(); }
        }
#if (GEMM_MASK >> 1) & 1
        { pg8::Gemm g{ACT, Wb + (rep ? W_D2 : W_D1), FF, FF, FF}; pg8::StaticOrder S; S.init(M / 256, 4, G, bx);
          EpiResid E{rep ? (const void*)HB : (const void*)x, rep, rep ? out : nullptr, rep ? nullptr : (bf16_t*)out, rep ? nullptr : ssqp, 0.5f};
          pg8::gemm_phase<EpiResid, pg8::StaticOrder, true, true>(lds, g, S, E); }
#endif
        }
        if (rep == 1) break;
        GSYNC();
        { PH_BEGIN
#if (GEMM_MASK >> 2) & 1
        { pg8::Gemm g{(const bf16_t*)out, Wb + W_IN, 1024, 1024, 1024}; pg8::StaticOrder S; S.init(M / 256, 15, G, bx);
          EpiProj E{ssqp, CQ, CKV, QN, KN, SGA, SGB, cqs, ckvs, args.in[14], args.in[15], lds, -1};
          pg8::gemm_phase<EpiProj, pg8::StaticOrder, true, true>(lds, g, S, E); }
#endif
#if (GEMM_MASK >> 3) & 1
        { pg8::Gemm g{Wb + W_INV, (const bf16_t*)out, 1024, 1024, 1024}; pg8::StaticOrder S; S.init(2, M / 256, G, bx); EpiColT<16> E{VTN, M, ssqp, 1.f / 1024.f};
          pg8::gemm_phase<EpiColT<16>, pg8::StaticOrder, true, true>(lds, g, S, E); }
#endif
        for (int task = (G == 256 ? bx - 128 : bx); task < 272; task += (G == 256 ? 128 : G)) { if (task < 0) break;
            const int n0 = 16 * task; f32x4 a, dmy;
            const bf16_t* wp = (n0 < 3840 ? Wb + W_IN + (size_t)(n0 + r16) * 1024 : Wb + W_INV + (size_t)(n0 - 3840 + r16) * 1024) + 8 * q4 + 128 * wave;
            skinny_tile(hmb + r16 * 1024 + 8 * q4 + 128 * wave, wp, nullptr, 128, a, dmy);
            META_REDUCE1(a)
            if (wave == 0) {
            const float rs = __builtin_amdgcn_rsqf(ld_agent(ssqm2 + r16) * (1.f / 1024.f) + EPS); const f32x4 v = a * rs; const size_t off = (size_t)r16 * 4352 + n0 + 4 * q4;
            *(f32x4*)(projm + off) = v; u32x2 w; w.x = pk2(v[0], v[1]); w.y = pk2(v[2], v[3]); *(u32x2*)(projmb + off) = w; }
            __syncthreads(); }
        }
        GSYNC();
        { PH_BEGIN
        for (int task = gw; task < 64; task += NGW) { const int isv = task >= 32, n0 = 16 * (task & 31); f32x4 a, dmy;
            float s = 0.f; { const float* cp = projm + (size_t)r16 * 4352 + 512 + 64 * q4;
#pragma unroll 4
                for (int i = 0; i < 64; i += 4) s += sumsq4(*(const f32x4*)(cp + i)); }
            s += __shfl_xor(s, 16); s += __shfl_xor(s, 32); const float rs = __builtin_amdgcn_rsqf(s * (1.f / 256.f) + EPS);
            skinny_tile(projmb + (size_t)r16 * 4352 + 512 + 8 * q4, Wb + (isv ? W_UV : W_UK) + (size_t)(n0 + r16) * 256 + 8 * q4, nullptr, 256, a, dmy);
            *(f32x4*)((isv ? kvmv : kvmk) + (size_t)r16 * 512 + n0 + 4 * q4) = a * rs; }
#if (GEMM_MASK >> 4) & 1
        { pg8::Gemm g{CQ, Wb + W_UQ, 512, 384, 384}; pg8::StaticOrder S; S.init(M / 256, 4, G, bx); EpiRowScale<8> E{QRAW, 1024, cqs, 1.f / 384.f};
          pg8::gemm_phase<EpiRowScale<8>, pg8::StaticOrder, true, true>(lds, g, S, E); }
#endif
#if (GEMM_MASK >> 5) & 1
        { pg8::Gemm g{CKV, Wb + W_UK, 256, 256, 256}; pg8::StaticOrder S; S.init(M / 256, 2, G, bx); EpiRowScale<4> E{KRAW, 512, ckvs, 1.f / 256.f};
          pg8::gemm_phase<EpiRowScale<4>, pg8::StaticOrder, true, true>(lds, g, S, E); }
#endif
#if (GEMM_MASK >> 6) & 1
        { pg8::Gemm g{Wb + W_UV, CKV, 256, 256, 256}; pg8::StaticOrder S; S.init(2, M / 256, G, bx); EpiColT<4> E{VTM, M, ckvs, 1.f / 256.f};
          pg8::gemm_phase<EpiColT<4>, pg8::StaticOrder, true, true>(lds, g, S, E); }
#endif
        }
        GSYNC();
        { PH_BEGIN
            const float* qg = args.in[12]; const float* kg = args.in[13];
            const int hh = lane >> 3, sub = lane & 7;
            for (int row = gw; row < M; row += NGW) {
                const int b = row >> 12, t = row & 4095, pos = 16 + t;
                float c0, s0, c1, s1; rope_cs(pos, 2 * sub, c0, s0); rope_cs(pos, 2 * sub + 1, c1, s1);
#pragma unroll
                for (int isk = 0; isk < 2; ++isk) {
                    const bf16_t* np = isk ? KRAW + (size_t)row * 512 + 64 * hh + 8 * sub : QRAW + (size_t)row * 1024 + 128 * hh + 8 * sub;
                    const bf16_t* rp = isk ? CQ + (size_t)row * 512 + 384 + 2 * sub : QRAW + (size_t)row * 1024 + 128 * hh + 64 + 2 * sub;
                    const u32x4 nv = *(const u32x4*)np; const unsigned lo = *(const unsigned*)rp, hi2 = *(const unsigned*)(rp + 16);
                    float v[8]; v[0] = __uint_as_float(nv.x << 16); v[1] = __uint_as_float(nv.x & 0xffff0000u); v[2] = __uint_as_float(nv.y << 16); v[3] = __uint_as_float(nv.y & 0xffff0000u);
                    v[4] = __uint_as_float(nv.z << 16); v[5] = __uint_as_float(nv.z & 0xffff0000u); v[6] = __uint_as_float(nv.w << 16); v[7] = __uint_as_float(nv.w & 0xffff0000u);
                    float a0 = __uint_as_float(lo << 16), a1 = __uint_as_float(lo & 0xffff0000u), b0 = __uint_as_float(hi2 << 16), b1 = __uint_as_float(hi2 & 0xffff0000u);
                    float s = (a0 * a0 + a1 * a1) + (b0 * b0 + b1 * b1);
#pragma unroll
                    for (int i = 0; i < 8; ++i) s += v[i] * v[i];
                    s += __shfl_xor(s, 1); s += __shfl_xor(s, 2); s += __shfl_xor(s, 4);
                    const float* gn = isk ? kg : qg;
                    const float rs = __builtin_amdgcn_rsqf(s * (1.f / 96.f) + EPS) * (isk ? 1.f : QSC_MLA);
                    const f32x4 g0 = *(const f32x4*)(gn + 8 * sub), g1 = *(const f32x4*)(gn + 8 * sub + 4);
                    const f32x2 gl = *(const f32x2*)(gn + 64 + 2 * sub), gh = *(const f32x2*)(gn + 80 + 2 * sub);
                    f32x4 o0, o1;
#pragma unroll
                    for (int i = 0; i < 4; ++i) { o0[i] = v[i] * rs * g0[i]; o1[i] = v[4 + i] * rs * g1[i]; }
                    a0 *= rs * gl[0]; a1 *= rs * gl[1]; b0 *= rs * gh[0]; b1 *= rs * gh[1];
                    const float l0 = a0 * c0 - b0 * s0, l1 = a1 * c1 - b1 * s1, h0 = a0 * s0 + b0 * c0, h1 = a1 * s1 + b1 * c1;
                    if (isk) { const int kap = swap23(t & 63), sw = (kap >> 2) & 3;
                        unsigned char* kt = (unsigned char*)KF + ((size_t)(b * 8 + hh) * 64 + (t >> 6)) * MLA_KT + kap * 192;
                        st16((bf16_t*)(kt + 16 * (sub ^ sw)), o0, o1); *(unsigned*)(kt + 16 * ((8 + (sub >> 2)) ^ sw) + 4 * (sub & 3)) = pk2(l0, l1); *(unsigned*)(kt + 16 * ((10 + (sub >> 2)) ^ sw) + 4 * (sub & 3)) = pk2(h0, h1);
                    } else { bf16_t* dst = QRAW + (size_t)row * 1024 + 128 * hh;
                        st16(dst + 8 * sub, o0, o1); *(unsigned*)(dst + 64 + 2 * sub) = pk2(l0, l1); *(unsigned*)(dst + 80 + 2 * sub) = pk2(h0, h1); }
                }
            }
            for (int task = gw; task < 128; task += NGW) {
                const int m = task >> 3, h = task & 7;
                const float kn_ = kvmk[(size_t)m * 512 + 64 * h + lane]; const float kr = lane < 32 ? projm[(size_t)m * 4352 + 384 + lane] : 0.f;
                const float rs = __builtin_amdgcn_rsqf(wave_sum(kn_ * kn_ + kr * kr) * (1.f / 96.f) + EPS);
                const int kapm = swap23(m), swm = (kapm >> 2) & 3; bf16_t* kmrow = kfm + ((size_t)h * 64 + kapm) * 96;
                kmrow[8 * ((lane >> 3) ^ swm) + (lane & 7)] = (bf16_t)(pk2(kn_ * rs * kg[lane], 0.f) & 0xffffu);
                const float xr = kr * rs * kg[64 + (lane & 31)]; const float pr = __shfl_xor(xr, 16);
                float c, s; rope_cs(m, lane & 15, c, s);
                const float orp = (lane & 16) ? (pr * s + xr * c) : (xr * c - pr * s);
                if (lane < 32) kmrow[8 * ((8 + (lane >> 3)) ^ swm) + (lane & 7)] = (bf16_t)(pk2(orp, 0.f) & 0xffffu);
                vtmm[((size_t)h * 64 + lane) * 64 + m] = (bf16_t)(pk2(kvmv[(size_t)m * 512 + 64 * h + lane], 0.f) & 0xffffu);
                const int colp = 1280 + 256 * (h >> 2) + 128 * (lane >> 5) + 32 * (h & 3) + (lane & 31);
                const float kv = projm[(size_t)m * 4352 + colp]; const float rn = __builtin_amdgcn_rsqf(wave_sum(kv * kv) * (1.f / 64.f) + EPS);
                knm[(size_t)m * 512 + 64 * h + lane] = (bf16_t)(pk2(kv * rn * args.in[15][lane], 0.f) & 0xffffu);
                vnmT[((size_t)64 * h + lane) * 16 + m] = (bf16_t)(pk2(projm[(size_t)m * 4352 + 3840 + 64 * h + lane], 0.f) & 0xffffu);
            }
        }
        GSYNC();
        { PH_BEGIN
#ifndef NO_MLA
        {
            LAS float* scr = (LAS float*)(lds + wave * 16384);
        constexpr int I_GU = 16 * 176, I_D = 44 * 32, I_IN = 16 * 120, I_INV = 16 * 16, I_UQ = 6 * 32, I_UK = 4 * 16, I_AB = 8 * 32, I_O = 16 * 32;
        constexpr int NITEMS = 2 * I_GU + 2 * I_D + I_IN + I_INV + I_UQ + 2 * I_UK + 2 * I_AB + I_O;
        for (int it = gw; it < NITEMS; it += NGW) {
            int r = it;
            { const bool late_ = (it >= I_GU && it < 2 * I_GU) || (it >= 2 * I_GU + I_D && it < 2 * I_GU + 2 * I_D) || it >= 2 * I_GU + 2 * I_D + I_IN + I_INV + I_UQ + 2 * I_UK; if (!late_) continue; }
            if (r < 2 * I_GU) { const int l2 = r >= I_GU; if (l2) r -= I_GU; const int kb = r / 176, nb = r % 176, n0 = 32 * nb, tile = n0 >> 8, half = (n0 >> 7) & 1, j = n0 & 127;
                const float* W = args.in[(l2 ? 21 : 3) + half]; tr_item(W, FF, 1024, args.in[l2 ? 20 : 2], Wb + (l2 ? W_GU2 : W_GU1), n0, 128 * tile + j, 64 * kb, scr, lane); continue; }
            r -= 2 * I_GU;
            if (r < 2 * I_D) { const int l2 = r >= I_D; if (l2) r -= I_D; const int kb = r / 32, nb = r % 32;
                tr_item(args.in[l2 ? 23 : 5], 1024, FF, nullptr, Wb + (l2 ? W_D2 : W_D1), 32 * nb, 32 * nb, 64 * kb, scr, lane); continue; }
            r -= 2 * I_D;
            if (r < I_IN) { const int kb = r / 120, nb = r % 120, n0 = 32 * nb; int src;
                if (n0 < 384) src = n0; else if (n0 < 416) src = 640 + (n0 - 384); else if (n0 < 512) src = -1; else if (n0 < 768) src = 384 + (n0 - 512);
                else if (n0 < 1792) { const bool isq = n0 < 1280; const int c = n0 - (isq ? 768 : 1280), t = c >> 8, cc = c & 255, bj = cc >> 7, wc = (cc & 127) >> 5; src = (isq ? 672 : 1184) + 64 * (4 * t + wc) + 32 * bj; }
                else if (n0 < 2816) src = 2208 + (n0 - 1792); else src = 3232 + (n0 - 2816);
                tr_item(args.in[7], 4256, 1024, args.in[6], Wb + W_IN, n0, src, 64 * kb, scr, lane); continue; }
            r -= I_IN;
            if (r < I_INV) { const int kb = r / 16, nb = r % 16; tr_item(args.in[7], 4256, 1024, args.in[6], Wb + W_INV, 32 * nb, 1696 + 32 * nb, 64 * kb, scr, lane); continue; }
            r -= I_INV;
            if (r < I_UQ) { const int kb = r / 32, nb = r % 32, n0 = 32 * nb, hh = n0 >> 7, j = n0 & 127; tr_item(args.in[9], 768, 384, args.in[8], Wb + W_UQ, n0, j < 96 ? 96 * hh + j : -1, 64 * kb, scr, lane); continue; }
            r -= I_UQ;
            if (r < 2 * I_UK) { const int isv = r >= I_UK; if (isv) r -= I_UK; const int kb = r / 16, nb = r % 16, n0 = 32 * nb, hh = n0 >> 6, j = n0 & 63;
                tr_item(args.in[11], 1024, 256, args.in[10], Wb + (isv ? W_UV : W_UK), n0, 128 * hh + (isv ? 64 : 0) + j, 64 * kb, scr, lane); continue; }
            r -= 2 * I_UK;
            if (r < 2 * I_AB) { const int isb = r >= I_AB; if (isb) r -= I_AB; const int kb = r / 32, nb = r % 32; tr_item(args.in[isb ? 18 : 17], 1024, 512, nullptr, Wb + (isb ? W_B : W_A), 32 * nb, 32 * nb, 64 * kb, scr, lane); continue; }
            r -= 2 * I_AB;
            { const int kb = r / 32, nb = r % 32; tr_item(args.in[19], 1024, 1024, nullptr, Wb + W_O, 32 * nb, 32 * nb, 64 * kb, scr, lane); }
        }
        }
        for (int i = tid; i < 8 * 465; i += 512) ((LAS float*)(lds + NA_BIAS_OFF))[i] = args.in[16][i] * LOG2E;
        __syncthreads();
        bool fix_mla, fix_na;
        { const float* qg = args.in[12]; const float* kg = args.in[13]; float a = fmaxf(fabsf(qg[lane]), lane < 32 ? fabsf(qg[64 + lane]) : 0.f), c = fmaxf(fabsf(kg[lane]), lane < 32 ? fabsf(kg[64 + lane]) : 0.f);
#pragma unroll
          for (int o_ = 1; o_ < 64; o_ <<= 1) { a = fmaxf(a, __shfl_xor(a, o_)); c = fmaxf(c, __shfl_xor(c, o_)); }
          fix_mla = __builtin_amdgcn_readfirstlane((int)(96.f * a * c * QSC_MLA < 60.f)) != 0;
          float e = fabsf(args.in[14][lane]), f = fabsf(args.in[15][lane]), g = 0.f;
          for (int i = lane; i < 8 * 465; i += 64) g = fmaxf(g, fabsf(args.in[16][i]));
#pragma unroll
          for (int o_ = 1; o_ < 64; o_ <<= 1) { e = fmaxf(e, __shfl_xor(e, o_)); f = fmaxf(f, __shfl_xor(f, o_)); g = fmaxf(g, __shfl_xor(g, o_)); }
          fix_na = __builtin_amdgcn_readfirstlane((int)(64.f * e * f * QSC_NA + g * LOG2E < 60.f)) != 0; }
#ifdef PROBE_MLA2
        for (int unit = bx; unit < 1024; unit += G) { const int bh = unit >> 4, qb = unit & 15; mla_unit(false, lds, bh >> 3, bh & 7, qb, QRAW, KF, kfm, VTM, vtmm, OA, tid, lane, wave); }
#endif
#define MLA_UNITS(FX) for (int unit = bx; unit < 1024; unit += G) { int bh = unit >> 4, qb = unit & 15; \
            if (G == 256) { const int xcd = bx & 7, slot = bx >> 3; bh = 16 * (unit >> 8) + 2 * xcd + (slot >> 4); qb = slot & 15; }     \
            mla_unit(FX, lds, bh >> 3, bh & 7, qb, QRAW, KF, kfm, VTM, vtmm, OA, tid, lane, wave); }
#if defined(T_MLA_T)
        MLA_UNITS(true)
#elif defined(T_MLA_F)
        MLA_UNITS(false)
#elif defined(T_MLA_N)
#else
#ifdef PROBE_NOFIX
        fix_mla = false; fix_na = false;
#endif
        MLA_UNITS(fix_mla)
#endif
#undef MLA_UNITS
#endif
#ifndef NO_NA
#define NA_UNITS(FX) for (int unit = ((G % 8 == 0) ? ((bx & 7) * (G >> 3) + (bx >> 3)) * 8 + wave : gw); unit < 4096; unit += NGW) { const int r = unit & 63, bh = unit >> 6;     na_unit<FX>(lds, lds + wave * 16384, bh >> 3, bh & 7, r, QN, KN, VTN, knm, vnmT, OB, lane); }
#if defined(T_NA_T)
        NA_UNITS(true)
#elif defined(T_NA_F)
        NA_UNITS(false)
#elif defined(T_NA_N)
#else
        if (fix_na) { NA_UNITS(true) } else { NA_UNITS(false) }
#ifdef PROBE_NA2
        NA_UNITS(fix_na)
#endif
#endif
#undef NA_UNITS
#endif
        }
        GSYNC();
        { PH_BEGIN
#if (GEMM_MASK >> 7) & 1
        for (int br = 0; br < 2; ++br) { pg8::Gemm g{br ? OB : OA, Wb + (br ? W_B : W_A), 512, 512, 512}; pg8::StaticOrder S; S.init(M / 256, 4, G, bx); EpiGate E{MERGED, br ? SGB : SGA, br};
          pg8::gemm_phase<EpiGate, pg8::StaticOrder, true, true>(lds, g, S, E); }
#endif
        }
        GSYNC();
        { PH_BEGIN
#if (GEMM_MASK >> 8) & 1
        { pg8::Gemm g{MERGED, Wb + W_O, 1024, 1024, 1024}; pg8::StaticOrder S; S.init(M / 256, 4, G, bx); EpiResid E{(const void*)out, 1, nullptr, HB, ssqp, 1.f};
          pg8::gemm_phase<EpiResid, pg8::StaticOrder, true, true>(lds, g, S, E); }
#endif
        }
        GSYNC();
    }
}

extern "C" void kernel_launch(void* const* d_in, const int* in_sizes, int n_in, void* d_out, int out_size, void* d_ws, size_t ws_size, hipStream_t stream) {
    static int grid = 0;
    if (grid == 0) {
        if (n_in != 24 || out_size != M * DM || ws_size < WS_END) { fprintf(stderr, "kernel_launch: unexpected shapes (n_in %d out %d ws %zu)\n", n_in, out_size, ws_size); grid = -1; return; }
        int dev = 0, cus = 0, per_cu = 0;
        hipGetDevice(&dev); hipDeviceGetAttribute(&cus, hipDeviceAttributeMultiprocessorCount, dev);
        hipFuncSetAttribute((const void*)mega_fwd, hipFuncAttributeMaxDynamicSharedMemorySize, LDS_BYTES);
        hipOccupancyMaxActiveBlocksPerMultiprocessor(&per_cu, (const void*)mega_fwd, 512, LDS_BYTES);
        if (per_cu < 1) per_cu = 1;
        grid = cus * per_cu; if (grid > 256) grid = 256;
        (void)hipGetLastError();
    }
    if (grid < 0) return;
    if (hipMemsetAsync((char*)d_ws + WS_BAR, 0, XCD_BAR_WORDS * 4, stream) != hipSuccess) { fprintf(stderr, "kernel_launch: memset of the barrier words failed\n"); return; }
    Args a{};
    for (int i = 0; i < 24; ++i) a.in[i] = (const float*)d_in[i];
    a.out = (float*)d_out; a.ws = (unsigned char*)d_ws;
    void* kargs[] = {&a};
    hipError_t e = hipLaunchCooperativeKernel((const void*)mega_fwd, dim3(grid), dim3(512), kargs, LDS_BYTES, stream);
    if (e != hipSuccess) fprintf(stderr, "cooperative launch failed: %s (grid %d)\n", hipGetErrorString(e), grid);
}
```

```cpp
#include <hip/hip_runtime.h>
#include <hip/hip_cooperative_groups.h>
#include <cstdio>
#include <cstdint>
namespace cg = cooperative_groups;

#define LAS __attribute__((address_space(3)))
typedef unsigned short bf16_t;
typedef short bf16x8 __attribute__((ext_vector_type(8)));
typedef float f32x4 __attribute__((ext_vector_type(4)));
typedef float f32x16 __attribute__((ext_vector_type(16)));
typedef float f32x2 __attribute__((ext_vector_type(2)));
typedef unsigned u32x4 __attribute__((ext_vector_type(4)));
typedef unsigned u32x2 __attribute__((ext_vector_type(2)));
typedef __bf16 bf16x2_t __attribute__((ext_vector_type(2)));

constexpr int M = 32768, DM = 1024, FF = 2816, TSEQ = 4096, NBATCH = 8;
constexpr float EPS = 1e-6f;
constexpr float LOG2E = 1.4426950408889634f;
constexpr float QSC_MLA = 0.10206207261596575f * LOG2E;
constexpr float QSC_NA = 0.125f * LOG2E;

__device__ __forceinline__ unsigned pk2(float lo, float hi) { f32x2 v = {lo, hi}; bf16x2_t b = __builtin_convertvector(v, bf16x2_t); return __builtin_bit_cast(unsigned, b); }
__device__ __forceinline__ float bf2f(unsigned short h) { return __uint_as_float(((unsigned)h) << 16); }
__device__ __forceinline__ void st16(bf16_t* p, f32x4 a, f32x4 b) { u32x4 w; w.x = pk2(a[0], a[1]); w.y = pk2(a[2], a[3]); w.z = pk2(b[0], b[1]); w.w = pk2(b[2], b[3]); *(u32x4*)p = w; }
__device__ __forceinline__ float sumsq4(f32x4 a) { return (a[0] * a[0] + a[1] * a[1]) + (a[2] * a[2] + a[3] * a[3]); }
__device__ __forceinline__ float sum4(f32x4 a) { return (a[0] + a[1]) + (a[2] + a[3]); }
__device__ __forceinline__ float sumN16(const float* p) { return (sum4(*(const f32x4*)p) + sum4(*(const f32x4*)(p + 4))) + (sum4(*(const f32x4*)(p + 8)) + sum4(*(const f32x4*)(p + 12))); }
__device__ __forceinline__ float sumN8(const float* p) { return sum4(*(const f32x4*)p) + sum4(*(const f32x4*)(p + 4)); }
__device__ __forceinline__ float sumN4(const float* p) { return sum4(*(const f32x4*)p); }
template <int N> __device__ __forceinline__ float sumN(const float* p) { if constexpr (N == 16) return sumN16(p); else if constexpr (N == 8) return sumN8(p); else return sumN4(p); }
__device__ __forceinline__ float silu_f(float g) { return g * __builtin_amdgcn_rcpf(1.f + __builtin_amdgcn_exp2f(-LOG2E * g)); }
__device__ __forceinline__ float sigm_f(float g) { return __builtin_amdgcn_rcpf(1.f + __builtin_amdgcn_exp2f(-LOG2E * g)); }
__device__ __forceinline__ float ld_agent(const float* p) { return __hip_atomic_load(p, __ATOMIC_RELAXED, __HIP_MEMORY_SCOPE_AGENT); }
__device__ __forceinline__ float wave_sum(float v) {
#pragma unroll
    for (int o = 1; o < 64; o <<= 1) v += __shfl_xor(v, o);
    return v;
}

namespace pg8 {
#define PG8_LAS __attribute__((address_space(3)))
constexpr int BM = 256, BK = 64, HALF = 128, HTB = HALF * BK * 2, STAGE_BYTES = 8 * HTB, NXCD = 8, WGM = 8;
__host__ __device__ __forceinline__ int lds_byte(int r, int c) { const int st = (r >> 4) * 2 + (c >> 5), rr = r & 15, cc = c & 31, ob = rr * 64 + cc * 2; return st * 1024 + (ob ^ (((ob >> 9) & 1) << 5)); }
__host__ __device__ __forceinline__ void stage_rc(int b, int& R, int& C) { const int st = b / 1024, sb = b % 1024, swz = sb ^ (((sb >> 9) & 1) << 5); R = (st >> 1) * 16 + swz / 64; C = (st & 1) * 32 + (swz % 64) / 2; }
__host__ __device__ __forceinline__ int perm32(int rho) { const int n = rho >> 4, i = rho & 15; return 8 * (i >> 2) + 4 * n + (i & 3); }
struct Unit { int pm, pn; };
struct Gemm { const bf16_t* A; const bf16_t* Bt; int lda, ldb, K; };
struct StaticOrder {
    int nM, nN, nwg, G, c;
    __device__ void init(int nM_, int nN_, int G_, int c_) { nM = nM_; nN = nN_; nwg = nM * nN; G = G_; c = c_; }
    __device__ bool next(int i, Unit& u) const {
        const long L = (long)i * G + c; if (L >= nwg) return false;
        int wgid = (int)L; { const int q = nwg / NXCD, r = nwg % NXCD, xcd = wgid % NXCD, off = wgid / NXCD; wgid = (xcd < r ? xcd * (q + 1) : r * (q + 1) + (xcd - r) * q) + off; }
        const int nig = WGM * nN, gid = wgid / nig, fm = gid * WGM, gsz = (nM - fm) < WGM ? (nM - fm) : WGM;
        u.pm = fm + ((wgid % nig) % gsz); u.pn = (wgid % nig) / gsz; return true;
    }
    __device__ __forceinline__ void a_ready(const Unit&) const {}
    __device__ __forceinline__ void done(const Unit&) const {}
};
template <class Epi, class Sched, bool ALIGN_EPI = false, bool SP2 = false>
__device__ __forceinline__ void gemm_phase(PG8_LAS unsigned char* lds, const Gemm g, const Sched& S, const Epi& E) {
    int tid_ = threadIdx.x; asm volatile("" : "+v"(tid_));
    const int tid = tid_, wid = __builtin_amdgcn_readfirstlane(tid >> 6), lane = tid & 63, wr = wid >> 2, wc = wid & 3, fr = lane & 15, fq = lane >> 4;
    const int K = g.K, nt = K / BK;
    unsigned voffA[2], voffB[2];
#pragma unroll
    for (int i = 0; i < 2; ++i) { int R, C; stage_rc(tid * 16 + i * 8192, R, C); const int Rb = Epi::PERM ? ((R & ~31) + perm32(R & 31)) : R;
        voffA[i] = (unsigned)(R * g.lda + C) * 2u; voffB[i] = (unsigned)(Rb * g.ldb + C) * 2u; }
    const size_t kstep = (size_t)(BK * 2);
    const size_t hstepA = (size_t)HALF * g.lda * 2, hstepB = (size_t)HALF * g.ldb * 2;
    const size_t tstepA = 2 * hstepA, tstepB = 2 * hstepB;
    const unsigned ldsw = (unsigned)wid * 1024u;
    const int aoff = lds_byte(wr * 64 + fr, fq * 8), boff = lds_byte(wc * 32 + fr, fq * 8);
#define PG8_SA(b, h) (((b) * 2 + (h)) * HTB)
#define PG8_SB(b, h) ((4 + (b) * 2 + (h)) * HTB)
#define PG8_STAGE(bufoff, gbase, voff) do { _Pragma("unroll") for (int _i = 0; _i < 2; ++_i) \
        __builtin_amdgcn_global_load_lds((const unsigned*)((const char*)(gbase) + (voff)[_i]), (PG8_LAS unsigned*)(lds + (bufoff) + ldsw + _i * 8192), 16, 0, 0); } while (0)
#define PG8_LDA(dst, b, h) do { _Pragma("unroll") for (int m = 0; m < 4; ++m) _Pragma("unroll") for (int k = 0; k < 2; ++k) dst[m][k] = *(const PG8_LAS bf16x8*)(lds + PG8_SA(b, h) + aoff + m * 2048 + k * 1024); } while (0)
#define PG8_LDB(dst, b, h) do { _Pragma("unroll") for (int n = 0; n < 2; ++n) _Pragma("unroll") for (int k = 0; k < 2; ++k) dst[n][k] = *(const PG8_LAS bf16x8*)(lds + PG8_SB(b, h) + boff + n * 2048 + k * 1024); } while (0)
#define PG8_MMA(ai, bj, At, Bt) do { __builtin_amdgcn_s_setprio(1); _Pragma("unroll") for (int m = 0; m < 4; ++m) _Pragma("unroll") for (int n = 0; n < 2; ++n) _Pragma("unroll") for (int k = 0; k < 2; ++k) \
        acc[ai][bj][m][n] = __builtin_amdgcn_mfma_f32_16x16x32_bf16(Bt[n][k], At[m][k], acc[ai][bj][m][n], 0, 0, 0); __builtin_amdgcn_s_setprio(0); } while (0)
#define PG8_WAIT_V(n) asm volatile("s_waitcnt vmcnt(" #n ")" ::: "memory")
#define PG8_WAIT_L(n) asm volatile("s_waitcnt lgkmcnt(" #n ")" ::: "memory")
#define PG8_BAR __builtin_amdgcn_s_barrier()
#define PG8_SCHED __builtin_amdgcn_sched_barrier(0)
    Unit cur, nxt; int ui = 0;
    if (!S.next(0, cur)) return;
    f32x4 acc[2][2][4][2];
#pragma unroll
    for (int a = 0; a < 2; ++a)
#pragma unroll
        for (int b = 0; b < 2; ++b)
#pragma unroll
            for (int m = 0; m < 4; ++m)
#pragma unroll
                for (int n = 0; n < 2; ++n) acc[a][b][m][n] = (f32x4){0.f, 0.f, 0.f, 0.f};
    bf16x8 At[4][2], B0[2][2], B1[2][2];
    const char* cA = (const char*)g.A + (size_t)cur.pm * tstepA; const char* cB = (const char*)g.Bt + (size_t)cur.pn * tstepB;
    S.a_ready(cur);
    if constexpr (SP2) {
        PG8_STAGE(PG8_SB(0, 0), cB, voffB); PG8_STAGE(PG8_SB(0, 1), cB + hstepB, voffB); PG8_STAGE(PG8_SA(0, 0), cA, voffA); PG8_STAGE(PG8_SA(0, 1), cA + hstepA, voffA);
        if (wr == 1) PG8_BAR;
        PG8_WAIT_V(2); PG8_BAR;
        PG8_STAGE(PG8_SB(1, 0), cB + kstep, voffB); PG8_STAGE(PG8_SA(1, 0), cA + kstep, voffA); PG8_STAGE(PG8_SB(1, 1), cB + hstepB + kstep, voffB);
        PG8_WAIT_V(6); PG8_BAR;
    } else {
        PG8_STAGE(PG8_SB(0, 0), cB, voffB); PG8_STAGE(PG8_SA(0, 0), cA, voffA); PG8_STAGE(PG8_SB(0, 1), cB + hstepB, voffB); PG8_STAGE(PG8_SA(0, 1), cA + hstepA, voffA);
        if (wr == 1) PG8_BAR;
        PG8_WAIT_V(4); PG8_BAR;
        PG8_STAGE(PG8_SB(1, 0), cB + kstep, voffB); PG8_STAGE(PG8_SA(1, 0), cA + kstep, voffA); PG8_STAGE(PG8_SB(1, 1), cB + hstepB + kstep, voffB);
        PG8_WAIT_V(6); PG8_BAR;
    }
    for (;;) {
        const bool has_next = S.next(ui + 1, nxt);
        const char* nA = has_next ? (const char*)g.A + (size_t)nxt.pm * tstepA : cA; const char* nB = has_next ? (const char*)g.Bt + (size_t)nxt.pn * tstepB : cB;
        for (int t = 0; t < nt; t += 2) {
            const bool last = (t == nt - 2);
            const char* a1 = cA + (size_t)(t + 1) * kstep;
            const char* a2 = last ? nA : cA + (size_t)(t + 2) * kstep; const char* b2 = last ? nB : cB + (size_t)(t + 2) * kstep;
            const char* a3 = a2 + kstep; const char* b3 = b2 + kstep;
            if (last && has_next) S.a_ready(nxt);
            if constexpr (SP2) {
            PG8_LDB(B0, 0, 0); PG8_LDB(B1, 0, 1); PG8_SCHED; PG8_LDA(At, 0, 0); PG8_STAGE(PG8_SA(1, 1), a1 + hstepA, voffA);
            PG8_WAIT_V(8); PG8_WAIT_L(0); PG8_BAR; PG8_MMA(0, 0, At, B0); PG8_MMA(0, 1, At, B1); PG8_BAR; PG8_SCHED;
            PG8_LDA(At, 0, 1); PG8_STAGE(PG8_SB(0, 0), b2, voffB); PG8_STAGE(PG8_SB(0, 1), b2 + hstepB, voffB); PG8_STAGE(PG8_SA(0, 0), a2, voffA);
            PG8_WAIT_V(8); PG8_WAIT_L(0); PG8_BAR; PG8_MMA(1, 0, At, B0); PG8_MMA(1, 1, At, B1); PG8_BAR; PG8_SCHED;
            PG8_LDB(B0, 1, 0); PG8_LDB(B1, 1, 1); PG8_SCHED; PG8_LDA(At, 1, 0); PG8_STAGE(PG8_SA(0, 1), a2 + hstepA, voffA);
            PG8_WAIT_V(8); PG8_WAIT_L(0); PG8_BAR; PG8_MMA(0, 0, At, B0); PG8_MMA(0, 1, At, B1); PG8_BAR; PG8_SCHED;
            PG8_LDA(At, 1, 1); PG8_STAGE(PG8_SB(1, 0), b3, voffB); PG8_STAGE(PG8_SB(1, 1), b3 + hstepB, voffB); PG8_STAGE(PG8_SA(1, 0), a3, voffA);
            PG8_WAIT_V(8); PG8_WAIT_L(0); PG8_BAR; PG8_MMA(1, 0, At, B0); PG8_MMA(1, 1, At, B1); PG8_BAR; PG8_SCHED;
            } else {
            PG8_LDB(B0, 0, 0); PG8_SCHED; PG8_LDA(At, 0, 0); PG8_STAGE(PG8_SA(1, 1), a1 + hstepA, voffA);
            PG8_WAIT_L(8); PG8_BAR; PG8_WAIT_L(0); PG8_MMA(0, 0, At, B0); PG8_BAR; PG8_SCHED;
            PG8_LDB(B1, 0, 1); PG8_STAGE(PG8_SB(0, 0), b2, voffB);
            PG8_BAR; PG8_WAIT_L(0); PG8_MMA(0, 1, At, B1); PG8_BAR;
            PG8_LDA(At, 0, 1); PG8_STAGE(PG8_SA(0, 0), a2, voffA);
            PG8_BAR; PG8_WAIT_L(0); PG8_MMA(1, 0, At, B0); PG8_BAR; PG8_SCHED;
            PG8_STAGE(PG8_SB(0, 1), b2 + hstepB, voffB);
            PG8_WAIT_V(6); PG8_BAR; PG8_MMA(1, 1, At, B1); PG8_BAR;
            PG8_LDB(B0, 1, 0); PG8_SCHED; PG8_LDA(At, 1, 0); PG8_STAGE(PG8_SA(0, 1), a2 + hstepA, voffA);
            PG8_WAIT_L(8); PG8_BAR; PG8_WAIT_L(0); PG8_MMA(0, 0, At, B0); PG8_BAR; PG8_SCHED;
            PG8_LDB(B1, 1, 1); PG8_STAGE(PG8_SB(1, 0), b3, voffB);
            PG8_BAR; PG8_WAIT_L(0); PG8_MMA(0, 1, At, B1); PG8_BAR;
            PG8_LDA(At, 1, 1); PG8_STAGE(PG8_SA(1, 0), a3, voffA);
            PG8_BAR; PG8_WAIT_L(0); PG8_MMA(1, 0, At, B0); PG8_BAR; PG8_SCHED;
            PG8_STAGE(PG8_SB(1, 1), b3 + hstepB, voffB);
            PG8_WAIT_V(6); PG8_BAR; PG8_MMA(1, 1, At, B1); PG8_BAR;
            }
        }
        if constexpr (ALIGN_EPI) { if (wr == 0) PG8_BAR; }
        if constexpr (!Epi::AFTER_DRAIN) { int t2_ = threadIdx.x; asm volatile("" : "+v"(t2_)); E(acc, cur, wr, wc, t2_ & 15, (t2_ & 63) >> 4); S.done(cur); }
        if (!has_next) break;
#pragma unroll
        for (int a = 0; a < 2; ++a)
#pragma unroll
            for (int b = 0; b < 2; ++b)
#pragma unroll
                for (int m = 0; m < 4; ++m)
#pragma unroll
                    for (int n = 0; n < 2; ++n) acc[a][b][m][n] = (f32x4){0.f, 0.f, 0.f, 0.f};
        cur = nxt; cA = nA; cB = nB; ++ui;
        if constexpr (ALIGN_EPI) { if (wr == 1) PG8_BAR; }
    }
    PG8_WAIT_V(0);
    if constexpr (!ALIGN_EPI) { if (wr == 0) PG8_BAR; }
    PG8_BAR;
    if constexpr (Epi::AFTER_DRAIN) { E.fused(acc, cur, wr, wc, fr, fq, lds, wid, lane); S.done(cur); }
#undef PG8_SA
#undef PG8_SB
#undef PG8_STAGE
#undef PG8_LDA
#undef PG8_LDB
#undef PG8_MMA
#undef PG8_WAIT_V
#undef PG8_WAIT_L
#undef PG8_BAR
#undef PG8_SCHED
}
}
using pg8::Unit;
typedef const f32x4 (&AccRef)[2][2][4][2];
#define EPI_COMMON static constexpr bool PERM = true, AFTER_DRAIN = false;

constexpr int RS_TAB_OFF = 131072 + 4096;
__device__ __forceinline__ const LAS float* rs_table(const float* ssqp, int pm, int& cpm, LAS unsigned char* ldsbase) {
    LAS float* tab = (LAS float*)(ldsbase + RS_TAB_OFF);
    if (pm != cpm) { cpm = pm; int t = threadIdx.x; asm volatile("" : "+v"(t));
        if (t < 256) tab[t] = __builtin_amdgcn_rsqf(sumN16(ssqp + ((size_t)pm * 256 + t) * 16) * (1.f / 1024.f) + EPS);
        asm volatile("s_waitcnt lgkmcnt(0)" ::: "memory"); __builtin_amdgcn_s_barrier(); asm volatile("" ::: "memory"); }
    return tab;
}
struct EpiSwiGLU { EPI_COMMON
    bf16_t* O; const float* ssqp; LAS unsigned char* ldsb; mutable int cpm;
    __device__ __forceinline__ void operator()(AccRef acc, const Unit& u, int wr, int wc, int fr, int fq) const {
        const int row0 = u.pm * 256 + wr * 64 + fr, col0 = u.pn * 128 + wc * 32 + 8 * fq;
        const LAS float* tab = nullptr; if (ssqp) tab = rs_table(ssqp, u.pm, cpm, ldsb);
#pragma unroll
        for (int ai = 0; ai < 2; ++ai)
#pragma unroll
            for (int m = 0; m < 4; ++m) {
                const int row = row0 + ai * 128 + m * 16;
                const float rs = ssqp ? tab[ai * 128 + wr * 64 + m * 16 + fr] : 1.f;
                f32x4 o[2];
#pragma unroll
                for (int n = 0; n < 2; ++n)
#pragma unroll
                    for (int i = 0; i < 4; ++i) o[n][i] = silu_f(acc[ai][0][m][n][i] * rs) * (acc[ai][1][m][n][i] * rs);
                st16(O + (size_t)row * FF + col0, o[0], o[1]);
            }
    }
};
struct EpiResid { EPI_COMMON
    const void* base; int base_bf16; float* out; bf16_t* hb; float* ssqp; float alpha;
    __device__ __forceinline__ void operator()(AccRef acc, const Unit& u, int wr, int wc, int fr, int fq) const {
        const int row0 = u.pm * 256 + wr * 64 + fr, col0 = u.pn * 256 + wc * 32 + 8 * fq;
#pragma unroll
        for (int ai = 0; ai < 2; ++ai)
#pragma unroll
            for (int m = 0; m < 4; ++m) {
                const int row = row0 + ai * 128 + m * 16; float s = 0.f;
#pragma unroll
                for (int bj = 0; bj < 2; ++bj) {
                    const size_t off = (size_t)row * DM + col0 + bj * 128;
                    f32x4 b0, b1;
                    if (base_bf16) { const u32x4 p = *(const u32x4*)((const bf16_t*)base + off);
                        b0[0] = __uint_as_float(p.x << 16); b0[1] = __uint_as_float(p.x & 0xffff0000u); b0[2] = __uint_as_float(p.y << 16); b0[3] = __uint_as_float(p.y & 0xffff0000u);
                        b1[0] = __uint_as_float(p.z << 16); b1[1] = __uint_as_float(p.z & 0xffff0000u); b1[2] = __uint_as_float(p.w << 16); b1[3] = __uint_as_float(p.w & 0xffff0000u); }
                    else { b0 = *(const f32x4*)((const float*)base + off); b1 = *(const f32x4*)((const float*)base + off + 4); }
                    const f32x4 v0 = b0 + alpha * acc[ai][bj][m][0], v1 = b1 + alpha * acc[ai][bj][m][1];
                    if (out) { __builtin_nontemporal_store(v0, (f32x4*)(out + off)); __builtin_nontemporal_store(v1, (f32x4*)(out + off + 4)); }
                    if (hb) st16(hb + off, v0, v1);
                    s += sumsq4(v0) + sumsq4(v1);
                }
                if (ssqp) { s += __shfl_xor(s, 16); s += __shfl_xor(s, 32); if (fq == 0) ssqp[(size_t)row * 16 + u.pn * 4 + wc] = s; }
            }
    }
};
struct EpiProj { EPI_COMMON
    const float* ssqp; bf16_t *cq, *ckv, *qn, *kn, *sga, *sgb; float *cqs, *ckvs; const float *qg, *kg; LAS unsigned char* ldsb; mutable int cpm;
    __device__ __forceinline__ void operator()(AccRef acc, const Unit& u, int wr, int wc, int fr, int fq) const {
        const int row0 = u.pm * 256 + wr * 64 + fr, pn = u.pn;
        const LAS float* tab = rs_table(ssqp, u.pm, cpm, ldsb);
#pragma unroll
        for (int ai = 0; ai < 2; ++ai)
#pragma unroll
            for (int m = 0; m < 4; ++m) {
                const int row = row0 + ai * 128 + m * 16;
                const float rs = tab[ai * 128 + wr * 64 + m * 16 + fr];
                f32x4 v[2][2];
#pragma unroll
                for (int bj = 0; bj < 2; ++bj)
#pragma unroll
                    for (int n = 0; n < 2; ++n) v[bj][n] = acc[ai][bj][m][n] * rs;
                if (pn <= 2) {
                    bf16_t* dst = pn < 2 ? cq + (size_t)row * 512 + pn * 256 : ckv + (size_t)row * 256;
#pragma unroll
                    for (int bj = 0; bj < 2; ++bj) st16(dst + bj * 128 + wc * 32 + 8 * fq, v[bj][0], v[bj][1]);
                    float s = sumsq4(v[0][0]) + sumsq4(v[0][1]); if (pn != 1) s += sumsq4(v[1][0]) + sumsq4(v[1][1]);
                    s += __shfl_xor(s, 16); s += __shfl_xor(s, 32);
                    if (fq == 0) { if (pn < 2) cqs[(size_t)row * 8 + pn * 4 + wc] = s; else ckvs[(size_t)row * 4 + wc] = s; }
                } else if (pn <= 6) {
                    const bool isq = pn <= 4; const int head = 4 * (isq ? pn - 3 : pn - 5) + wc;
                    float s = (sumsq4(v[0][0]) + sumsq4(v[0][1])) + (sumsq4(v[1][0]) + sumsq4(v[1][1]));
                    s += __shfl_xor(s, 16); s += __shfl_xor(s, 32);
                    const float hr = __builtin_amdgcn_rsqf(s * (1.f / 64.f) + EPS) * (isq ? QSC_NA : 1.f);
                    const float* gain = isq ? qg : kg; bf16_t* dst = (isq ? qn : kn) + (size_t)row * 512 + 64 * head;
#pragma unroll
                    for (int bj = 0; bj < 2; ++bj) { const int d0 = 32 * bj + 8 * fq; const f32x4 g0 = *(const f32x4*)(gain + d0), g1 = *(const f32x4*)(gain + d0 + 4);
                        st16(dst + d0, v[bj][0] * hr * g0, v[bj][1] * hr * g1); }
                } else {
                    const int t = pn - 7; bf16_t* dst = (t < 4 ? sga : sgb) + (size_t)row * DM + (t & 3) * 256 + wc * 32 + 8 * fq;
#pragma unroll
                    for (int bj = 0; bj < 2; ++bj) { f32x4 a, b;
#pragma unroll
                        for (int i = 0; i < 4; ++i) { a[i] = sigm_f(v[bj][0][i]); b[i] = sigm_f(v[bj][1][i]); }
                        st16(dst + bj * 128, a, b); }
                }
            }
    }
};
template <int NST> struct EpiColT { EPI_COMMON
    bf16_t* O; int ldo; const float* st; float inv_n;
    __device__ __forceinline__ void operator()(AccRef acc, const Unit& u, int wr, int wc, int fr, int fq) const {
        const int row0 = u.pm * 256 + wr * 64 + fr, tok0 = u.pn * 256 + wc * 32 + 8 * fq;
#pragma unroll
        for (int bj = 0; bj < 2; ++bj)
#pragma unroll
            for (int n = 0; n < 2; ++n) {
                float cs[4];
#pragma unroll
                for (int e = 0; e < 4; ++e) cs[e] = __builtin_amdgcn_rsqf(sumN<NST>(st + (size_t)(tok0 + bj * 128 + 4 * n + e) * NST) * inv_n + EPS);
#pragma unroll
                for (int ai = 0; ai < 2; ++ai)
#pragma unroll
                    for (int m = 0; m < 4; ++m) {
                        const int row = row0 + ai * 128 + m * 16; u32x2 w;
                        w.x = pk2(acc[ai][bj][m][n][0] * cs[0], acc[ai][bj][m][n][1] * cs[1]); w.y = pk2(acc[ai][bj][m][n][2] * cs[2], acc[ai][bj][m][n][3] * cs[3]);
                        *(u32x2*)(O + (size_t)row * ldo + tok0 + bj * 128 + 4 * n) = w;
                    }
            }
    }
};
template <int NST> struct EpiRowScale { EPI_COMMON
    bf16_t* O; int ldo; const float* st; float inv_n;
    __device__ __forceinline__ void operator()(AccRef acc, const Unit& u, int wr, int wc, int fr, int fq) const {
        const int row0 = u.pm * 256 + wr * 64 + fr, col0 = u.pn * 256 + wc * 32 + 8 * fq;
#pragma unroll
        for (int ai = 0; ai < 2; ++ai)
#pragma unroll
            for (int m = 0; m < 4; ++m) {
                const int row = row0 + ai * 128 + m * 16;
                const float rs = __builtin_amdgcn_rsqf(sumN<NST>(st + (size_t)row * NST) * inv_n + EPS);
#pragma unroll
                for (int bj = 0; bj < 2; ++bj) st16(O + (size_t)row * ldo + col0 + bj * 128, acc[ai][bj][m][0] * rs, acc[ai][bj][m][1] * rs);
            }
    }
};
struct EpiGate { EPI_COMMON
    bf16_t* merged; const bf16_t* sg; int second;
    __device__ __forceinline__ void operator()(AccRef acc, const Unit& u, int wr, int wc, int fr, int fq) const {
        const int row0 = u.pm * 256 + wr * 64 + fr, col0 = u.pn * 256 + wc * 32 + 8 * fq;
#pragma unroll
        for (int ai = 0; ai < 2; ++ai)
#pragma unroll
            for (int m = 0; m < 4; ++m) {
                const int row = row0 + ai * 128 + m * 16;
#pragma unroll
                for (int bj = 0; bj < 2; ++bj) {
                    const size_t off = (size_t)row * DM + col0 + bj * 128;
                    const u32x4 g = *(const u32x4*)(sg + off);
                    f32x4 a, b;
                    a[0] = __uint_as_float(g.x << 16) * acc[ai][bj][m][0][0]; a[1] = __uint_as_float(g.x & 0xffff0000u) * acc[ai][bj][m][0][1];
                    a[2] = __uint_as_float(g.y << 16) * acc[ai][bj][m][0][2]; a[3] = __uint_as_float(g.y & 0xffff0000u) * acc[ai][bj][m][0][3];
                    b[0] = __uint_as_float(g.z << 16) * acc[ai][bj][m][1][0]; b[1] = __uint_as_float(g.z & 0xffff0000u) * acc[ai][bj][m][1][1];
                    b[2] = __uint_as_float(g.w << 16) * acc[ai][bj][m][1][2]; b[3] = __uint_as_float(g.w & 0xffff0000u) * acc[ai][bj][m][1][3];
                    if (second) { const u32x4 p = *(const u32x4*)(merged + off);
                        a[0] += __uint_as_float(p.x << 16); a[1] += __uint_as_float(p.x & 0xffff0000u); a[2] += __uint_as_float(p.y << 16); a[3] += __uint_as_float(p.y & 0xffff0000u);
                        b[0] += __uint_as_float(p.z << 16); b[1] += __uint_as_float(p.z & 0xffff0000u); b[2] += __uint_as_float(p.w << 16); b[3] += __uint_as_float(p.w & 0xffff0000u); }
                    st16(merged + off, a, b);
                }
            }
    }
};
constexpr size_t MiB = 1u << 20;
constexpr size_t WS_SMALL = 0, WS_W = 2 * MiB, WS_SSQP = 50 * MiB, WS_CQS = 52 * MiB, WS_CKVS = 53 * MiB, WS_HB = 54 * MiB, WS_VTM = 54 * MiB, WS_KRAW = 86 * MiB,
                 WS_A = 118 * MiB, WS_SGA = 118 * MiB, WS_SGB = 182 * MiB, WS_KF = 246 * MiB, WS_CQ = 294 * MiB, WS_CKV = 326 * MiB, WS_QN = 342 * MiB, WS_KN = 374 * MiB,
                 WS_VTN = 406 * MiB, WS_QRAW = 438 * MiB, WS_END = 502 * MiB;
constexpr size_t SM_SSQM1 = 0, SM_SSQM2 = 256, SM_XMB = 1024, SM_ACTM = SM_XMB + 16 * 1024 * 2, SM_HM = SM_ACTM + 16 * 2816 * 2, SM_HMB = SM_HM + 16 * 1024 * 4, SM_PROJM = SM_HMB + 16 * 1024 * 2,
                 SM_PROJMB = SM_PROJM + 16 * 4352 * 4, SM_KVMK = SM_PROJMB + 16 * 4352 * 2, SM_KVMV = SM_KVMK + 16 * 512 * 4, SM_KFM = SM_KVMV + 16 * 512 * 4, SM_VTMM = SM_KFM + 8 * 64 * 96 * 2,
                 SM_KNM = SM_VTMM + 8 * 64 * 64 * 2, SM_VNMT = SM_KNM + 16 * 512 * 2, SM_END = SM_VNMT + 512 * 16 * 2;
static_assert(SM_END <= 1 * MiB, "small region");
constexpr size_t WS_BAR = 1 * MiB;
constexpr size_t W_GU1 = 0, W_D1 = W_GU1 + (size_t)5632 * 1024, W_IN = W_D1 + (size_t)1024 * 2816, W_INV = W_IN + (size_t)3840 * 1024, W_UQ = W_INV + (size_t)512 * 1024,
                 W_UK = W_UQ + (size_t)1024 * 384, W_UV = W_UK + (size_t)512 * 256, W_A = W_UV + (size_t)512 * 256, W_B = W_A + (size_t)1024 * 512, W_O = W_B + (size_t)1024 * 512,
                 W_GU2 = W_O + (size_t)1024 * 1024, W_D2 = W_GU2 + (size_t)5632 * 1024, W_ENDE = W_D2 + (size_t)1024 * 2816;
static_assert(W_ENDE * 2 <= 48 * MiB, "weights region");

__device__ __forceinline__ void tr_item(const float* W, int N, int K, const float* gain, bf16_t* WT, int dst_row0, int src_col0, int k0, LAS float* scr, int lane) {
    const int kr = lane >> 3, c4 = (lane & 7) * 4;
    f32x4 v[8];
#pragma unroll
    for (int i = 0; i < 8; ++i) { const int kk = 8 * i + kr; v[i] = (f32x4){0.f, 0.f, 0.f, 0.f};
        if (src_col0 >= 0) { v[i] = *(const f32x4*)(W + (size_t)(k0 + kk) * N + src_col0 + c4); if (gain) v[i] = v[i] * gain[k0 + kk]; } }
#pragma unroll
    for (int i = 0; i < 8; ++i) { LAS float* d = scr + (8 * i + kr) * 33 + c4; d[0] = v[i][0]; d[1] = v[i][1]; d[2] = v[i][2]; d[3] = v[i][3]; }
    asm volatile("s_waitcnt lgkmcnt(0)" ::: "memory");
    const int c = lane & 7;
#pragma unroll
    for (int j = 0; j < 4; ++j) { const int n = (lane >> 3) + 8 * j; const LAS float* s = scr + (8 * c) * 33 + n;
        u32x4 o; o.x = pk2(s[0 * 33], s[1 * 33]); o.y = pk2(s[2 * 33], s[3 * 33]); o.z = pk2(s[4 * 33], s[5 * 33]); o.w = pk2(s[6 * 33], s[7 * 33]);
        *(u32x4*)(WT + (size_t)(dst_row0 + n) * K + k0 + 8 * c) = o; }
    asm volatile("s_waitcnt lgkmcnt(0)" ::: "memory");
}
__device__ __forceinline__ float row_to_bf16(const float* xrow, bf16_t* orow, int lane) {
    const f32x4* xr = (const f32x4*)xrow + lane; f32x4 v[4]; float s = 0.f;
#pragma unroll
    for (int j = 0; j < 4; ++j) { v[j] = xr[64 * j]; s += sumsq4(v[j]); }
    const float tot = wave_sum(s), rr = __builtin_amdgcn_rsqf(tot * (1.f / 1024.f) + EPS);
    u32x2* o8 = (u32x2*)orow + lane;
#pragma unroll
    for (int j = 0; j < 4; ++j) { u32x2 w; w.x = pk2(v[j][0] * rr, v[j][1] * rr); w.y = pk2(v[j][2] * rr, v[j][3] * rr); o8[64 * j] = w; }
    return tot;
}
__device__ __forceinline__ void rows2_to_bf16(const float* x0, const float* x1, bf16_t* o0, bf16_t* o1, int lane, float& s0, float& s1) {
    const f32x4* a = (const f32x4*)x0 + lane; const f32x4* b = (const f32x4*)x1 + lane; f32x4 v[4], w[4];
#pragma unroll
    for (int j = 0; j < 4; ++j) { v[j] = a[64 * j]; w[j] = b[64 * j]; }
    float p = 0.f, q = 0.f;
#pragma unroll
    for (int j = 0; j < 4; ++j) { p += sumsq4(v[j]); q += sumsq4(w[j]); }
#pragma unroll
    for (int o = 1; o < 64; o <<= 1) { p += __shfl_xor(p, o); q += __shfl_xor(q, o); }
    s0 = p; s1 = q;
    const float r0 = __builtin_amdgcn_rsqf(p * (1.f / 1024.f) + EPS), r1 = __builtin_amdgcn_rsqf(q * (1.f / 1024.f) + EPS);
    u32x2* d0 = (u32x2*)o0 + lane; u32x2* d1 = (u32x2*)o1 + lane;
#pragma unroll
    for (int j = 0; j < 4; ++j) { u32x2 t; t.x = pk2(v[j][0] * r0, v[j][1] * r0); t.y = pk2(v[j][2] * r0, v[j][3] * r0); d0[64 * j] = t; t.x = pk2(w[j][0] * r1, w[j][1] * r1); t.y = pk2(w[j][2] * r1, w[j][3] * r1); d1[64 * j] = t; }
}
__device__ __forceinline__ f32x4 mfma16(bf16x8 a, bf16x8 b, f32x4 c) { return __builtin_amdgcn_mfma_f32_16x16x32_bf16(a, b, c, 0, 0, 0); }
__device__ __forceinline__ f32x16 mfma32(bf16x8 a, bf16x8 b, f32x16 c) { return __builtin_amdgcn_mfma_f32_32x32x16_bf16(a, b, c, 0, 0, 0); }
__device__ __forceinline__ void skinny_tile(const bf16_t* xp, const bf16_t* wp0, const bf16_t* wp1, int K, f32x4& a0, f32x4& a1) {
    a0 = (f32x4){0.f, 0.f, 0.f, 0.f}; a1 = a0;
#pragma unroll 4
    for (int k0 = 0; k0 < K; k0 += 32) {
        const bf16x8 x = *(const bf16x8*)(xp + k0); const bf16x8 w0 = *(const bf16x8*)(wp0 + k0); a0 = mfma16(w0, x, a0);
        if (wp1) { const bf16x8 w1 = *(const bf16x8*)(wp1 + k0); a1 = mfma16(w1, x, a1); }
    }
}
__device__ __forceinline__ void rope_cs(int pos, int i, float& c, float& s) {
    const float inv = exp2f(-(float)i * (13.287712379549449f / 16.f));
    const float ang = (float)pos * inv;
    double rev = (double)ang * 0.15915494309189535; rev -= __builtin_rint(rev);
    const float r = (float)rev; c = __builtin_amdgcn_cosf(r); s = __builtin_amdgcn_sinf(r);
}
__device__ __forceinline__ int crow(int r, int hi) { return (r & 3) + 8 * (r >> 2) + 4 * hi; }
__device__ __forceinline__ bf16x8 pack8(const f32x16& p, int base) {
    u32x4 w; w.x = pk2(p[base], p[base + 1]); w.y = pk2(p[base + 2], p[base + 3]); w.z = pk2(p[base + 4], p[base + 5]); w.w = pk2(p[base + 6], p[base + 7]); return __builtin_bit_cast(bf16x8, w);
}
__device__ __forceinline__ float max16(const f32x16& p) {
    float a = fmaxf(fmaxf(p[0], p[1]), fmaxf(p[2], p[3])), b = fmaxf(fmaxf(p[4], p[5]), fmaxf(p[6], p[7])), c = fmaxf(fmaxf(p[8], p[9]), fmaxf(p[10], p[11])), d = fmaxf(fmaxf(p[12], p[13]), fmaxf(p[14], p[15]));
    return fmaxf(fmaxf(a, b), fmaxf(c, d));
}
constexpr int MLA_KT = 12288, MLA_VT = 8192, MLA_BUF = MLA_KT + MLA_VT;
__device__ __forceinline__ int swap23(int k) { return (k & ~12) | ((k & 4) << 1) | ((k & 8) >> 1); }
__device__ __forceinline__ void mla_unit(const bool FIXED, LAS unsigned char* lds, int b, int h, int qb, const bf16_t* Qf, const bf16_t* Kf, const bf16_t* Kfm, const bf16_t* vT, const bf16_t* vTm, bf16_t* oa, int tid, int lane, int wid) {
    const int r32 = lane & 31, hi = lane >> 5;
    const size_t qrow = (size_t)b * TSEQ + qb * 256 + wid * 32 + r32;
    bf16x8 qr[6];
#pragma unroll
    for (int d0 = 0; d0 < 6; ++d0) qr[d0] = *(const bf16x8*)(Qf + qrow * 1024 + 128 * h + 16 * d0 + 8 * hi);
    const unsigned char* Ksrc = (const unsigned char*)Kf + ((size_t)(b * 8 + h) * 64) * MLA_KT + 16 * lane;
    const unsigned char* Kmsrc = (const unsigned char*)Kfm + (size_t)h * MLA_KT + 16 * lane;
    const int vd = 8 * wid + (lane >> 3), vg = (lane & 7) ^ ((vd >> 1) & 7);
    const bf16_t* Vsrc = vT + (size_t)(64 * h + vd) * M + (size_t)b * TSEQ + 8 * vg;
    const bf16_t* Vmsrc = vTm + (size_t)(64 * h + vd) * 64 + 8 * vg;
#define MLA_DMA(j, buf) do { LAS unsigned char* bp_ = lds + (buf) * MLA_BUF; const unsigned char* ks_ = (j) < 64 ? Ksrc + (size_t)(j) * MLA_KT : Kmsrc; const bf16_t* vs_ = (j) < 64 ? Vsrc + 64 * (j) : Vmsrc; \
        __builtin_amdgcn_global_load_lds((const unsigned*)(ks_ + 1024 * wid), (LAS unsigned*)(bp_ + 1024 * wid), 16, 0, 0); \
        if (wid < 4) __builtin_amdgcn_global_load_lds((const unsigned*)(ks_ + 1024 * (8 + wid)), (LAS unsigned*)(bp_ + 1024 * (8 + wid)), 16, 0, 0); \
        __builtin_amdgcn_global_load_lds((const unsigned*)vs_, (LAS unsigned*)(bp_ + MLA_KT + 1024 * wid), 16, 0, 0); } while (0)
    const int ksw = (r32 >> 2) & 3, vsw0 = (r32 >> 1) & 7;
    LAS unsigned char* const kbase0 = lds + r32 * 192 + 16 * (hi ^ ksw);
    LAS unsigned char* const kbase1 = lds + r32 * 192 + 16 * ((2 + hi) ^ ksw);
    LAS unsigned char* const vb0 = lds + 4 * MLA_KT + r32 * 128 + 16 * ((0 + hi) ^ vsw0);
    LAS unsigned char* const vb1 = lds + 4 * MLA_KT + r32 * 128 + 16 * ((2 + hi) ^ vsw0);
    LAS unsigned char* const vb2 = lds + 4 * MLA_KT + r32 * 128 + 16 * ((4 + hi) ^ vsw0);
    LAS unsigned char* const vb3 = lds + 4 * MLA_KT + r32 * 128 + 16 * ((6 + hi) ^ vsw0);
    float mrun = 0.f;
    f32x16 o0, o1, o2, sa, sb, zz;
#pragma unroll
    for (int i = 0; i < 16; ++i) { o0[i] = 0.f; o1[i] = 0.f; o2[i] = 0.f; zz[i] = 0.f; }
    const short one_ = (r32 == 0) ? (short)0x3F80 : (short)0; const bf16x8 onesf = {one_, one_, one_, one_, one_, one_, one_, one_};
#define KFRAG(slot, d0, half) (*(const LAS bf16x8*)(((d0) & 1 ? kbase1 : kbase0) + (slot) * MLA_KT + 64 * ((d0) >> 1) + 6144 * (half)))
#define VFRAG(slot, s_, db) (*(const LAS bf16x8*)(((s_) == 0 ? vb0 : (s_) == 1 ? vb1 : (s_) == 2 ? vb2 : vb3) + (slot) * MLA_VT + 4096 * (db)))
#define MLA_REF(first, S0, S1) do { _Pragma("unroll") for (int i = 0; i < 16; ++i) { S0[i] -= mrun; S1[i] -= mrun; } \
        float tm_ = fmaxf(max16(S0), max16(S1)); tm_ = fmaxf(tm_, __shfl_xor(tm_, 32)); \
        if ((first) || __any(tm_ > 8.f)) { const float dl_ = (first) ? tm_ : fmaxf(tm_, 0.f); mrun += dl_; const float al_ = __builtin_amdgcn_exp2f(-dl_); \
            _Pragma("unroll") for (int i = 0; i < 16; ++i) { S0[i] -= dl_; S1[i] -= dl_; o0[i] *= al_; o1[i] *= al_; o2[i] *= al_; } } } while (0)
#define SGB(mask, n) __builtin_amdgcn_sched_group_barrier(mask, n, 0)
#define MLA_BODY(J, PAR, HASNEXT, NEXTMETA) do { \
        f32x16 na, nb; bf16x8 kf[12], vf[8]; \
        if (HASNEXT) { _Pragma("unroll") for (int d0 = 0; d0 < 6; ++d0) { kf[2 * d0] = KFRAG(((PAR) + 1) % 4, d0, 0); kf[2 * d0 + 1] = KFRAG(((PAR) + 1) % 4, d0, 1); } } \
        if (HASNEXT) { na = mfma32(kf[0], qr[0], zz); nb = mfma32(kf[1], qr[0], zz); \
            _Pragma("unroll") for (int d0 = 1; d0 < 6; ++d0) { na = mfma32(kf[2 * d0], qr[d0], na); nb = mfma32(kf[2 * d0 + 1], qr[d0], nb); } } \
        _Pragma("unroll") for (int i = 0; i < 16; i += 2) { sa[i] = __builtin_amdgcn_exp2f(sa[i]); sa[i + 1] = __builtin_amdgcn_exp2f(sa[i + 1]); sb[i] = __builtin_amdgcn_exp2f(sb[i]); sb[i + 1] = __builtin_amdgcn_exp2f(sb[i + 1]); } \
        if (HASNEXT) { SGB(0x100, 12); _Pragma("unroll") for (int q_ = 0; q_ < 12; ++q_) { SGB(0x002, 5); SGB(0x008, 1); } } \
        __builtin_amdgcn_sched_barrier(0); \
        _Pragma("unroll") for (int s_ = 0; s_ < 4; ++s_) { vf[2 * s_] = VFRAG(PAR, s_, 0); vf[2 * s_ + 1] = VFRAG(PAR, s_, 1); } \
        { const bf16x8 pb0 = pack8(sa, 0), pb1 = pack8(sa, 8), pb2 = pack8(sb, 0), pb3 = pack8(sb, 8); \
          o0 = mfma32(vf[0], pb0, o0); o1 = mfma32(vf[1], pb0, o1); o2 = mfma32(onesf, pb0, o2); o0 = mfma32(vf[2], pb1, o0); o1 = mfma32(vf[3], pb1, o1); o2 = mfma32(onesf, pb1, o2); \
          o0 = mfma32(vf[4], pb2, o0); o1 = mfma32(vf[5], pb2, o1); o2 = mfma32(onesf, pb2, o2); o0 = mfma32(vf[6], pb3, o0); o1 = mfma32(vf[7], pb3, o1); o2 = mfma32(onesf, pb3, o2); } \
        SGB(0x100, 8); SGB(0x002, 4); _Pragma("unroll") for (int q_ = 0; q_ < 3; ++q_) { SGB(0x008, 3); SGB(0x002, 4); } SGB(0x008, 3); \
        if (HASNEXT) { if (NEXTMETA) { _Pragma("unroll") for (int i = 0; i < 16; ++i) { if (crow(i, hi) >= 16) na[i] = -INFINITY; nb[i] = -INFINITY; } } \
            if (!FIXED) MLA_REF(false, na, nb); sa = na; sb = nb; } \
        __builtin_amdgcn_sched_barrier(0); } while (0)
#define TILE_K(T, SLOT, KIND) do { if (KIND) { const unsigned char* ks_ = (KIND) == 1 ? Ksrc + (size_t)(T) * MLA_KT : Kmsrc; LAS unsigned char* kd_ = lds + (SLOT) * MLA_KT; \
        __builtin_amdgcn_global_load_lds((const unsigned*)(ks_ + 1024 * wid), (LAS unsigned*)(kd_ + 1024 * wid), 16, 0, 0); \
        if (wid < 4) __builtin_amdgcn_global_load_lds((const unsigned*)(ks_ + 1024 * k2piece), (LAS unsigned*)(kd_ + 1024 * k2piece), 16, 0, 0); } } while (0)
#define TILE_V(T, SLOT, KIND) do { if (KIND) { const bf16_t* vs_ = (KIND) == 1 ? Vsrc + 64 * (T) : Vmsrc; \
        __builtin_amdgcn_global_load_lds((const unsigned*)vs_, (LAS unsigned*)(lds + 4 * MLA_KT + (SLOT) * MLA_VT + 1024 * wid), 16, 0, 0); } } while (0)
#define PAIR_DMA(J, P4, K3, K4, V2, V3) do { TILE_K((J) + 3, ((P4) + 3) % 4, K3); TILE_V((J) + 2, ((P4) + 2) % 4, V2); TILE_K((J) + 4, (P4), K4); TILE_V((J) + 3, ((P4) + 3) % 4, V3); } while (0)
#define PAIR_END() do { asm volatile("s_waitcnt vmcnt(0)" ::: "memory"); __syncthreads(); __builtin_amdgcn_sched_barrier(0); } while (0)
    const int k2piece = wid < 4 ? 8 + wid : wid;
    {
#pragma unroll
        for (int t = 0; t < 3; ++t) { const unsigned char* ks_ = Ksrc + (size_t)t * MLA_KT; LAS unsigned char* kd_ = lds + t * MLA_KT;
            __builtin_amdgcn_global_load_lds((const unsigned*)(ks_ + 1024 * wid), (LAS unsigned*)(kd_ + 1024 * wid), 16, 0, 0);
            if (wid < 4) __builtin_amdgcn_global_load_lds((const unsigned*)(ks_ + 1024 * k2piece), (LAS unsigned*)(kd_ + 1024 * k2piece), 16, 0, 0); }
        __builtin_amdgcn_global_load_lds((const unsigned*)Vsrc, (LAS unsigned*)(lds + 4 * MLA_KT + 1024 * wid), 16, 0, 0);
        __builtin_amdgcn_global_load_lds((const unsigned*)(Vsrc + 64), (LAS unsigned*)(lds + 4 * MLA_KT + MLA_VT + 1024 * wid), 16, 0, 0);
    }
    asm volatile("s_waitcnt vmcnt(0)" ::: "memory"); __syncthreads();
    {
#pragma unroll
        for (int d0 = 0; d0 < 6; ++d0) { const bf16x8 ka_ = KFRAG(0, d0, 0), kb_ = KFRAG(0, d0, 1);
            if (d0 == 0) { sa = mfma32(ka_, qr[0], zz); sb = mfma32(kb_, qr[0], zz); } else { sa = mfma32(ka_, qr[d0], sa); sb = mfma32(kb_, qr[d0], sb); } }
        if (!FIXED) MLA_REF(true, sa, sb);
    }
    __syncthreads();
    for (int j = 0; j < 60; j += 4) {
        PAIR_DMA(j, 0, 1, 1, 1, 1);     MLA_BODY(j, 0, 1, 0);     MLA_BODY(j + 1, 1, 1, 0); PAIR_END();
        PAIR_DMA(j + 2, 2, 1, 1, 1, 1); MLA_BODY(j + 2, 2, 1, 0); MLA_BODY(j + 3, 3, 1, 0); PAIR_END(); }
    PAIR_DMA(60, 0, 1, 2, 1, 1); MLA_BODY(60, 0, 1, 0); MLA_BODY(61, 1, 1, 0); PAIR_END();
    PAIR_DMA(62, 2, 0, 0, 2, 0); MLA_BODY(62, 2, 1, 0); MLA_BODY(63, 3, 1, 1); PAIR_END();
    MLA_BODY(64, 0, 0, 0); __syncthreads();
#undef PAIR_DMA
#undef PAIR_END
#undef TILE_K
#undef TILE_V
#undef MLA_BODY
#undef MLA_REF
#undef KFRAG
#undef VFRAG
#undef SGB
#undef MLA_DMA
    const float lt = o2[0] + __shfl_xor(o2[0], 32), inv = 1.f / lt;
    bf16_t* orow = oa + qrow * 512 + 64 * h + 4 * hi;
#pragma unroll
    for (int g = 0; g < 4; ++g) {
        u32x2 w0, w1; w0.x = pk2(o0[4 * g] * inv, o0[4 * g + 1] * inv); w0.y = pk2(o0[4 * g + 2] * inv, o0[4 * g + 3] * inv);
        w1.x = pk2(o1[4 * g] * inv, o1[4 * g + 1] * inv); w1.y = pk2(o1[4 * g + 2] * inv, o1[4 * g + 3] * inv);
        *(u32x2*)(orow + 8 * g) = w0; *(u32x2*)(orow + 32 + 8 * g) = w1;
    }
}
constexpr int NA_BIAS_OFF = 131072 + 256;
#define NA_LOAD(KB, KF, VF) do { if ((KB) < 0) { \
            _Pragma("unroll") for (int d0 = 0; d0 < 4; ++d0) { u32x4 z = {0u, 0u, 0u, 0u}; if (r32 < 16) z = *(const u32x4*)(knm + swap23(r32) * 512 + 64 * h + 16 * d0 + 8 * hi); KF[d0] = __builtin_bit_cast(bf16x8, z); } \
            _Pragma("unroll") for (int db = 0; db < 2; ++db) { VF[0][db] = *(const bf16x8*)(vnmT + (size_t)(64 * h + 32 * db + r32) * 16 + 8 * hi); VF[1][db] = __builtin_bit_cast(bf16x8, (u32x4){0u, 0u, 0u, 0u}); } \
        } else { const size_t ktok = (size_t)b * TSEQ + 64 * (rs + ((KB) >> 1)) + 32 * ((KB) & 1); \
            _Pragma("unroll") for (int d0 = 0; d0 < 4; ++d0) KF[d0] = *(const bf16x8*)(kn + (ktok + swap23(r32)) * 512 + 64 * h + 16 * d0 + 8 * hi); \
            _Pragma("unroll") for (int s = 0; s < 2; ++s) _Pragma("unroll") for (int db = 0; db < 2; ++db) VF[s][db] = *(const bf16x8*)(vTn + (size_t)(64 * h + 32 * db + r32) * M + ktok + 16 * s + 8 * hi); } } while (0)
template <bool FIXED> __device__ __forceinline__ void na_unit(LAS unsigned char* lds, LAS unsigned char* wl, int b, int h, int r, const bf16_t* qn, const bf16_t* kn, const bf16_t* vTn, const bf16_t* knm, const bf16_t* vnmT, bf16_t* ob, int lane) {
    const int r32 = lane & 31, hi = lane >> 5;
    const size_t tok0 = (size_t)b * TSEQ + 64 * r;
    bf16x8 qr[2][4];
#pragma unroll
    for (int qb = 0; qb < 2; ++qb)
#pragma unroll
        for (int d0 = 0; d0 < 4; ++d0) qr[qb][d0] = *(const bf16x8*)(qn + (tok0 + 32 * qb + r32) * 512 + 64 * h + 16 * d0 + 8 * hi);
    int rs = r - 4; rs = rs < 0 ? 0 : (rs > 56 ? 56 : rs);
    float mrun[2] = {0.f, 0.f}, lrun[2] = {0.f, 0.f};
    f32x16 o[2][2];
#pragma unroll
    for (int a = 0; a < 2; ++a)
#pragma unroll
        for (int c = 0; c < 2; ++c)
#pragma unroll
            for (int i = 0; i < 16; ++i) o[a][c][i] = 0.f;
    const LAS float* bt = (const LAS float*)(lds + NA_BIAS_OFF) + h * 465 + (rs - r + 7) * 31;
    const int r3 = lane >> 3;
    const bf16_t* ksrc = kn + ((size_t)b * TSEQ + 64 * rs) * 512 + 64 * h + (size_t)((r3 & 3) + 8 * ((r3 >> 2) & 1)) * 512;
    const int kp0 = 8 * ((lane & 7) ^ (r3 >> 1)), kp1 = 8 * ((lane & 7) ^ (4 + (r3 >> 1)));
    const bf16_t* vsrc = vTn + (size_t)(64 * h + (lane >> 2)) * M + (size_t)b * TSEQ + 64 * rs + 8 * ((lane & 3) ^ ((lane >> 4) & 3));
#define NA_DMA(KB, BUF) do { const int to_ = 64 * ((KB) >> 1) + 32 * ((KB) & 1); LAS unsigned char* kd_ = wl + (BUF) * 8192; \
        _Pragma("unroll") for (int n = 0; n < 4; ++n) __builtin_amdgcn_global_load_lds((const unsigned*)(ksrc + (size_t)(to_ + 4 * (n & 1) + 16 * (n >> 1)) * 512 + ((n & 1) ? kp1 : kp0)), (LAS unsigned*)(kd_ + 1024 * n), 16, 0, 0); \
        _Pragma("unroll") for (int n = 0; n < 4; ++n) __builtin_amdgcn_global_load_lds((const unsigned*)(vsrc + (size_t)(16 * n) * M + to_), (LAS unsigned*)(kd_ + 4096 + 1024 * n), 16, 0, 0); } while (0)
    const int ksw = (r32 >> 1) & 7, vsw = (r32 >> 2) & 3;
    bf16x8 kf[4], vf[2][2];
    NA_LOAD(-1, kf, vf);
    NA_DMA(0, 0);
#define NA_QB(QB, I0, I1, IS_META, KB, KCBC) do { f32x16 p; \
        _Pragma("unroll") for (int i = 0; i < 16; ++i) p[i] = 0.f; \
        _Pragma("unroll") for (int d0 = 0; d0 < 4; ++d0) p = mfma32(kf[d0], qr[QB][d0], p); \
        if (IS_META) { _Pragma("unroll") for (int i = 0; i < 16; ++i) if (crow(i, hi) >= 16) p[i] = -INFINITY; } \
        else { const int c = 32 * (QB) + r32; int cs = c - 8; cs = cs < 0 ? 0 : (cs > 48 ? 48 : cs); \
            const int krel = 32 * (KCBC) + 8 * hi - cs; const LAS float* brow = bt + 31 * ((KB) >> 1) + (32 * (KCBC) + 8 * hi - c + 15); \
            _Pragma("unroll") for (int i = (I0); i < (I1); ++i) { const int off = (i & 3) + 4 * ((i >> 2) & 1) + 16 * (i >> 3); const bool ok = (unsigned)(krel + off) < 16u; \
                const float pv = p[i] + brow[off]; p[i] = ok ? pv : -INFINITY; } } \
        if constexpr (!FIXED) { float tm = -INFINITY; _Pragma("unroll") for (int i = (I0); i < (I1); ++i) tm = fmaxf(tm, p[i]); tm = fmaxf(tm, __shfl_xor(tm, 32)); \
            if ((IS_META) || __any(tm - mrun[QB] > 8.f)) { const float mnew = (IS_META) ? tm : fmaxf(mrun[QB], tm), alpha = __builtin_amdgcn_exp2f(mrun[QB] - mnew); mrun[QB] = mnew; lrun[QB] *= alpha; \
                _Pragma("unroll") for (int i = 0; i < 16; ++i) { o[QB][0][i] *= alpha; o[QB][1][i] *= alpha; } } } \
        float ls0 = 0.f, ls1 = 0.f; const float mr = FIXED ? 0.f : mrun[QB]; \
        _Pragma("unroll") for (int i = (I0); i < (I1); i += 2) { p[i] = __builtin_amdgcn_exp2f(p[i] - mr); p[i + 1] = __builtin_amdgcn_exp2f(p[i + 1] - mr); ls0 += p[i]; ls1 += p[i + 1]; } \
        lrun[QB] += ls0 + ls1; \
        if ((I0) == 0) { const bf16x8 pb0 = pack8(p, 0); o[QB][0] = mfma32(vf[0][0], pb0, o[QB][0]); o[QB][1] = mfma32(vf[0][1], pb0, o[QB][1]); } \
        if ((I1) == 16 && !(IS_META)) { const bf16x8 pb1 = pack8(p, 8); o[QB][0] = mfma32(vf[1][0], pb1, o[QB][0]); o[QB][1] = mfma32(vf[1][1], pb1, o[QB][1]); } } while (0)
#define NA_FETCH(KB) do { asm volatile("s_waitcnt vmcnt(0)" ::: "memory"); \
        const LAS unsigned char* bp = wl + ((KB) & 1) * 8192; \
        _Pragma("unroll") for (int d0 = 0; d0 < 4; ++d0) kf[d0] = *(const LAS bf16x8*)(bp + r32 * 128 + 16 * ((2 * d0 + hi) ^ ksw)); \
        _Pragma("unroll") for (int s = 0; s < 2; ++s) _Pragma("unroll") for (int db = 0; db < 2; ++db) vf[s][db] = *(const LAS bf16x8*)(bp + 4096 + (32 * db + r32) * 64 + 16 * ((2 * s + hi) ^ vsw)); \
        if ((KB) + 1 < 16) NA_DMA((KB) + 1, ((KB) + 1) & 1); } while (0)
    NA_QB(0, 0, 16, 1, -1, 0); NA_QB(1, 0, 16, 1, -1, 0);
    for (int kb = 0; kb < 16; kb += 2) {
        NA_FETCH(kb);     NA_QB(0, 0, 16, 0, kb, 0);     NA_QB(1, 8, 16, 0, kb, 0);
        NA_FETCH(kb + 1); NA_QB(0, 0, 8, 0, kb + 1, 1);  NA_QB(1, 0, 16, 0, kb + 1, 1);
    }
#undef NA_QB
#undef NA_FETCH
#pragma unroll
    for (int qb = 0; qb < 2; ++qb) {
        const float lt = lrun[qb] + __shfl_xor(lrun[qb], 32), inv = 1.f / lt;
        bf16_t* orow = ob + (tok0 + 32 * qb + r32) * 512 + 64 * h + 4 * hi;
#pragma unroll
        for (int g = 0; g < 4; ++g) {
            u32x2 w0, w1; w0.x = pk2(o[qb][0][4 * g] * inv, o[qb][0][4 * g + 1] * inv); w0.y = pk2(o[qb][0][4 * g + 2] * inv, o[qb][0][4 * g + 3] * inv);
            w1.x = pk2(o[qb][1][4 * g] * inv, o[qb][1][4 * g + 1] * inv); w1.y = pk2(o[qb][1][4 * g + 2] * inv, o[qb][1][4 * g + 3] * inv);
            *(u32x2*)(orow + 8 * g) = w0; *(u32x2*)(orow + 32 + 8 * g) = w1;
        }
    }
}
#undef NA_LOAD
#undef NA_DMA
#define XB_TMO      128
#define XB_XCNT(j)  (256  + 64 * (j))
#define XB_XSUB(j)  (1280 + 64 * (j))
#define XB_XGEN(j)  (2304 + 64 * (j))
#define XB_TOP      3328
#define XB_TOPGEN   3392
#define XCD_BAR_WORDS 3456
#define XB_SPIN_CAP (1u << 18)

__device__ __forceinline__ unsigned xb_ld(unsigned* p)              { return __hip_atomic_load(p, __ATOMIC_RELAXED, __HIP_MEMORY_SCOPE_AGENT); }
__device__ __forceinline__ unsigned xb_add(unsigned* p, unsigned v) { return __hip_atomic_fetch_add(p, v, __ATOMIC_RELAXED, __HIP_MEMORY_SCOPE_AGENT); }
__device__ __forceinline__ unsigned xb_xcc_id() { return (unsigned)__builtin_amdgcn_s_getreg((3 << 11) | 20) & 0xFu; }
#define XB_SPIN(cond, bar) do { unsigned _sp = 0; while (cond) { __builtin_amdgcn_s_sleep(1); \
    if ((++_sp & 255u) == 0u) { if (xb_ld(&(bar)[XB_TMO])) break; if (_sp > XB_SPIN_CAP) { atomicAdd(&(bar)[XB_TMO], 1u); break; } } } } while (0)

struct XcdBarrier {
    unsigned* bar; unsigned x;
    volatile LAS unsigned* st;
};

__device__ __forceinline__ XcdBarrier xcd_barrier_post(unsigned* bar, volatile LAS unsigned* st) {
    XcdBarrier b; b.bar = bar; b.x = (unsigned)__builtin_amdgcn_readfirstlane((int)xb_xcc_id()); b.st = st;
    if (threadIdx.x == 0) (void)xb_add(&bar[XB_XCNT(b.x)], 1u);
    return b;
}
__device__ __forceinline__ void xcd_barrier_complete(unsigned* bar, unsigned x, unsigned& nloc, unsigned& nx) {
    const unsigned G = gridDim.x * gridDim.y * gridDim.z;
    unsigned sum, cnt, mine, sp = 0u;
    for (;;) {
        sum = 0u; cnt = 0u; mine = 0u;
#pragma unroll
        for (unsigned j = 0; j < 16; ++j) { const unsigned c = xb_ld(&bar[XB_XCNT(j)]); sum += c; cnt += (c > 0u) ? 1u : 0u; mine = (j == x) ? c : mine; }
        if (sum == G) break;
        __builtin_amdgcn_s_sleep(1);
        if ((++sp & 255u) == 0u) { if (xb_ld(&bar[XB_TMO])) break; if (sp > XB_SPIN_CAP) { atomicAdd(&bar[XB_TMO], 1u); break; } }
    }
    nloc = mine > 0u ? mine : 1u; nx = cnt > 0u ? cnt : 1u;
}

__device__ __forceinline__ void xcd_barrier(const XcdBarrier& b) {
    asm volatile("s_waitcnt vmcnt(0)" ::: "memory");
    __syncthreads();
    if (threadIdx.x == 0) {
        unsigned* bar = b.bar;
        __builtin_amdgcn_s_waitcnt(0);
        unsigned nloc = b.st[0], nx = b.st[1];
        if (nloc == 0u) { xcd_barrier_complete(bar, b.x, nloc, nx); b.st[0] = nloc; b.st[1] = nx; }
        const unsigned old = xb_add(&bar[XB_XSUB(b.x)], 1u);
        const unsigned gen = old / nloc;
        if (old + 1u == (gen + 1u) * nloc) {
            __builtin_amdgcn_fence(__ATOMIC_RELEASE, "agent");
            asm volatile("s_waitcnt vmcnt(0)" ::: "memory");
            const unsigned og = xb_add(&bar[XB_TOP], 1u);
            const unsigned tg = og / nx;
            if (og + 1u == (tg + 1u) * nx) xb_add(&bar[XB_TOPGEN], 1u);
            else XB_SPIN(xb_ld(&bar[XB_TOPGEN]) == tg, bar);
            __builtin_amdgcn_fence(__ATOMIC_ACQUIRE, "agent");
            xb_add(&bar[XB_XGEN(b.x)], 1u);
            asm volatile("s_waitcnt vmcnt(0)" ::: "memory");
        } else {
            XB_SPIN(xb_ld(&bar[XB_XGEN(b.x)]) == gen, bar);
            __builtin_amdgcn_fence(__ATOMIC_ACQUIRE, "agent");
            asm volatile("s_waitcnt vmcnt(0)" ::: "memory");
        }
    }
    __syncthreads();
}

struct Args { const float* in[24]; float* out; unsigned char* ws; };
constexpr int LDS_BYTES = 147456;
#define GSYNC() do { XcdBarrier b_ = xbar; unsigned zo_ = 0u; asm volatile("" : "+s"(zo_)); b_.bar = b_.bar + zo_; unsigned xo_ = b_.x; asm volatile("" : "+s"(xo_)); b_.x = xo_; xcd_barrier(b_); } while (0)
#ifndef GEMM_MASK
#define GEMM_MASK 0xffff
#endif

__global__ void __launch_bounds__(512, 2) mega_fwd(Args args) {
    extern __shared__ __attribute__((aligned(16))) unsigned char lds_raw[];
    LAS unsigned char* lds = (LAS unsigned char*)lds_raw;
    cg::grid_group grid = cg::this_grid();
    float* const out = args.out; const float* const x = args.in[0];
    volatile LAS unsigned* MISC = (volatile LAS unsigned*)(lds + 147392);
    if (threadIdx.x < 4) MISC[threadIdx.x] = 0u;
    __syncthreads();
    XcdBarrier xbar; xbar.bar = (unsigned*)(args.ws + WS_BAR); xbar.x = 0; xbar.st = MISC;
#define PH_BEGIN int tid = threadIdx.x; asm volatile("" : "+v"(tid)); unsigned zoff_ = 0u; asm volatile("" : "+s"(zoff_)); unsigned char* ws = args.ws + zoff_; \
    const int lane = tid & 63, wave = __builtin_amdgcn_readfirstlane(tid >> 6), r16 = lane & 15, q4 = lane >> 4; \
    const int G = gridDim.x, bx = blockIdx.x; const int gw = bx * 8 + wave, NGW = G * 8; (void)r16; (void)q4; (void)gw; (void)NGW; (void)lane;
#define Wb ((bf16_t*)(ws + WS_W))
#define HB ((bf16_t*)(ws + WS_HB))
#define ACT ((bf16_t*)(ws + WS_A))
#define ssqp ((float*)(ws + WS_SSQP))
#define cqs ((float*)(ws + WS_CQS))
#define ckvs ((float*)(ws + WS_CKVS))
#define CQ ((bf16_t*)(ws + WS_CQ))
#define CKV ((bf16_t*)(ws + WS_CKV))
#define QN ((bf16_t*)(ws + WS_QN))
#define KN ((bf16_t*)(ws + WS_KN))
#define SGA ((bf16_t*)(ws + WS_SGA))
#define SGB ((bf16_t*)(ws + WS_SGB))
#define VTN ((bf16_t*)(ws + WS_VTN))
#define QRAW ((bf16_t*)(ws + WS_QRAW))
#define KRAW ((bf16_t*)(ws + WS_KRAW))
#define VTM ((bf16_t*)(ws + WS_VTM))
#define KF ((bf16_t*)(ws + WS_KF))
#define OA CQ
#define OB KRAW
#define MERGED QRAW
#define sm (ws + WS_SMALL)
#define ssqm1 ((float*)(sm + SM_SSQM1))
#define ssqm2 ((float*)(sm + SM_SSQM2))
#define xmb ((bf16_t*)(sm + SM_XMB))
#define actm ((bf16_t*)(sm + SM_ACTM))
#define hm ((float*)(sm + SM_HM))
#define hmb ((bf16_t*)(sm + SM_HMB))
#define projm ((float*)(sm + SM_PROJM))
#define projmb ((bf16_t*)(sm + SM_PROJMB))
#define kvmk ((float*)(sm + SM_KVMK))
#define kvmv ((float*)(sm + SM_KVMV))
#define kfm ((bf16_t*)(sm + SM_KFM))
#define vtmm ((bf16_t*)(sm + SM_VTMM))
#define knm ((bf16_t*)(sm + SM_KNM))
#define vnmT ((bf16_t*)(sm + SM_VNMT))

    { PH_BEGIN
        LAS float* scr = (LAS float*)(lds + wave * 16384);
        constexpr int I_GU = 16 * 176, I_D = 44 * 32, I_IN = 16 * 120, I_INV = 16 * 16, I_UQ = 6 * 32, I_UK = 4 * 16, I_AB = 8 * 32, I_O = 16 * 32;
        constexpr int NITEMS = 2 * I_GU + 2 * I_D + I_IN + I_INV + I_UQ + 2 * I_UK + 2 * I_AB + I_O;
        for (int it = gw; it < NITEMS; it += NGW) {
            int r = it;
            { const bool late_ = (it >= I_GU && it < 2 * I_GU) || (it >= 2 * I_GU + I_D && it < 2 * I_GU + 2 * I_D) || it >= 2 * I_GU + 2 * I_D + I_IN + I_INV + I_UQ + 2 * I_UK; if (late_) continue; }
            if (r < 2 * I_GU) { const int l2 = r >= I_GU; if (l2) r -= I_GU; const int kb = r / 176, nb = r % 176, n0 = 32 * nb, tile = n0 >> 8, half = (n0 >> 7) & 1, j = n0 & 127;
                const float* W = args.in[(l2 ? 21 : 3) + half]; tr_item(W, FF, 1024, args.in[l2 ? 20 : 2], Wb + (l2 ? W_GU2 : W_GU1), n0, 128 * tile + j, 64 * kb, scr, lane); continue; }
            r -= 2 * I_GU;
            if (r < 2 * I_D) { const int l2 = r >= I_D; if (l2) r -= I_D; const int kb = r / 32, nb = r % 32;
                tr_item(args.in[l2 ? 23 : 5], 1024, FF, nullptr, Wb + (l2 ? W_D2 : W_D1), 32 * nb, 32 * nb, 64 * kb, scr, lane); continue; }
            r -= 2 * I_D;
            if (r < I_IN) { const int kb = r / 120, nb = r % 120, n0 = 32 * nb; int src;
                if (n0 < 384) src = n0; else if (n0 < 416) src = 640 + (n0 - 384); else if (n0 < 512) src = -1; else if (n0 < 768) src = 384 + (n0 - 512);
                else if (n0 < 1792) { const bool isq = n0 < 1280; const int c = n0 - (isq ? 768 : 1280), t = c >> 8, cc = c & 255, bj = cc >> 7, wc = (cc & 127) >> 5; src = (isq ? 672 : 1184) + 64 * (4 * t + wc) + 32 * bj; }
                else if (n0 < 2816) src = 2208 + (n0 - 1792); else src = 3232 + (n0 - 2816);
                tr_item(args.in[7], 4256, 1024, args.in[6], Wb + W_IN, n0, src, 64 * kb, scr, lane); continue; }
            r -= I_IN;
            if (r < I_INV) { const int kb = r / 16, nb = r % 16; tr_item(args.in[7], 4256, 1024, args.in[6], Wb + W_INV, 32 * nb, 1696 + 32 * nb, 64 * kb, scr, lane); continue; }
            r -= I_INV;
            if (r < I_UQ) { const int kb = r / 32, nb = r % 32, n0 = 32 * nb, hh = n0 >> 7, j = n0 & 127; tr_item(args.in[9], 768, 384, args.in[8], Wb + W_UQ, n0, j < 96 ? 96 * hh + j : -1, 64 * kb, scr, lane); continue; }
            r -= I_UQ;
            if (r < 2 * I_UK) { const int isv = r >= I_UK; if (isv) r -= I_UK; const int kb = r / 16, nb = r % 16, n0 = 32 * nb, hh = n0 >> 6, j = n0 & 63;
                tr_item(args.in[11], 1024, 256, args.in[10], Wb + (isv ? W_UV : W_UK), n0, 128 * hh + (isv ? 64 : 0) + j, 64 * kb, scr, lane); continue; }
            r -= 2 * I_UK;
            if (r < 2 * I_AB) { const int isb = r >= I_AB; if (isb) r -= I_AB; const int kb = r / 32, nb = r % 32; tr_item(args.in[isb ? 18 : 17], 1024, 512, nullptr, Wb + (isb ? W_B : W_A), 32 * nb, 32 * nb, 64 * kb, scr, lane); continue; }
            r -= 2 * I_AB;
            { const int kb = r / 32, nb = r % 32; tr_item(args.in[19], 1024, 1024, nullptr, Wb + W_O, 32 * nb, 32 * nb, 64 * kb, scr, lane); }
        }
        for (int m = gw; m < M; m += 2 * NGW) {
            const int m1 = m + NGW; float s0, s1;
            if (m1 >= M) { s0 = row_to_bf16(x + (size_t)m * DM, HB + (size_t)m * DM, lane); if (lane < 16) ssqp[(size_t)m * 16 + lane] = lane == 0 ? s0 : 0.f; continue; }
            rows2_to_bf16(x + (size_t)m * DM, x + (size_t)m1 * DM, HB + (size_t)m * DM, HB + (size_t)m1 * DM, lane, s0, s1);
            if (lane < 16) { ssqp[(size_t)m * 16 + lane] = lane == 0 ? s0 : 0.f; ssqp[(size_t)m1 * 16 + lane] = lane == 0 ? s1 : 0.f; } }
        if (gw < 16) { const float s = row_to_bf16(args.in[1] + (size_t)gw * DM, xmb + (size_t)gw * DM, lane); if (lane == 0) ssqm1[gw] = s; }
        { const int gt = bx * 512 + tid, NGT = G * 512;
          if (gt < 16) ssqm2[gt] = 0.f;
          for (int i = gt; i < (8 * 64 * 96) / 8; i += NGT) ((u32x4*)kfm)[i] = (u32x4){0u, 0u, 0u, 0u};
          for (int i = gt; i < (8 * 64 * 64) / 8; i += NGT) ((u32x4*)vtmm)[i] = (u32x4){0u, 0u, 0u, 0u}; }
    }
#ifdef PROBE_P02
    GSYNC();
    { PH_BEGIN
        LAS float* scr = (LAS float*)(lds + wave * 16384);
        constexpr int I_GU = 16 * 176, I_D = 44 * 32, I_IN = 16 * 120, I_INV = 16 * 16, I_UQ = 6 * 32, I_UK = 4 * 16, I_AB = 8 * 32, I_O = 16 * 32;
        constexpr int NITEMS = 2 * I_GU + 2 * I_D + I_IN + I_INV + I_UQ + 2 * I_UK + 2 * I_AB + I_O;
        for (int it = gw; it < NITEMS; it += NGW) {
            int r = it;
            if (r < 2 * I_GU) { const int l2 = r >= I_GU; if (l2) r -= I_GU; const int kb = r / 176, nb = r % 176, n0 = 32 * nb, tile = n0 >> 8, half = (n0 >> 7) & 1, j = n0 & 127;
                const float* W = args.in[(l2 ? 21 : 3) + half]; tr_item(W, FF, 1024, args.in[l2 ? 20 : 2], Wb + (l2 ? W_GU2 : W_GU1), n0, 128 * tile + j, 64 * kb, scr, lane); continue; }
            r -= 2 * I_GU;
            if (r < 2 * I_D) { const int l2 = r >= I_D; if (l2) r -= I_D; const int kb = r / 32, nb = r % 32;
                tr_item(args.in[l2 ? 23 : 5], 1024, FF, nullptr, Wb + (l2 ? W_D2 : W_D1), 32 * nb, 32 * nb, 64 * kb, scr, lane); continue; }
            r -= 2 * I_D;
            if (r < I_IN) { const int kb = r / 120, nb = r % 120, n0 = 32 * nb; int src;
                if (n0 < 384) src = n0; else if (n0 < 416) src = 640 + (n0 - 384); else if (n0 < 512) src = -1; else if (n0 < 768) src = 384 + (n0 - 512);
                else if (n0 < 1792) { const bool isq = n0 < 1280; const int c = n0 - (isq ? 768 : 1280), t = c >> 8, cc = c & 255, bj = cc >> 7, wc = (cc & 127) >> 5; src = (isq ? 672 : 1184) + 64 * (4 * t + wc) + 32 * bj; }
                else if (n0 < 2816) src = 2208 + (n0 - 1792); else src = 3232 + (n0 - 2816);
                tr_item(args.in[7], 4256, 1024, args.in[6], Wb + W_IN, n0, src, 64 * kb, scr, lane); continue; }
            r -= I_IN;
            if (r < I_INV) { const int kb = r / 16, nb = r % 16; tr_item(args.in[7], 4256, 1024, args.in[6], Wb + W_INV, 32 * nb, 1696 + 32 * nb, 64 * kb, scr, lane); continue; }
            r -= I_INV;
            if (r < I_UQ) { const int kb = r / 32, nb = r % 32, n0 = 32 * nb, hh = n0 >> 7, j = n0 & 127; tr_item(args.in[9], 768, 384, args.in[8], Wb + W_UQ, n0, j < 96 ? 96 * hh + j : -1, 64 * kb, scr, lane); continue; }
            r -= I_UQ;
            if (r < 2 * I_UK) { const int isv = r >= I_UK; if (isv) r -= I_UK; const int kb = r / 16, nb = r % 16, n0 = 32 * nb, hh = n0 >> 6, j = n0 & 63;
                tr_item(args.in[11], 1024, 256, args.in[10], Wb + (isv ? W_UV : W_UK), n0, 128 * hh + (isv ? 64 : 0) + j, 64 * kb, scr, lane); continue; }
            r -= 2 * I_UK;
            if (r < 2 * I_AB) { const int isb = r >= I_AB; if (isb) r -= I_AB; const int kb = r / 32, nb = r % 32; tr_item(args.in[isb ? 18 : 17], 1024, 512, nullptr, Wb + (isb ? W_B : W_A), 32 * nb, 32 * nb, 64 * kb, scr, lane); continue; }
            r -= 2 * I_AB;
            { const int kb = r / 32, nb = r % 32; tr_item(args.in[19], 1024, 1024, nullptr, Wb + W_O, 32 * nb, 32 * nb, 64 * kb, scr, lane); }
        }
        for (int m = gw; m < M + 16; m += NGW) {
            if (m < M) { const float s = row_to_bf16(x + (size_t)m * DM, HB + (size_t)m * DM, lane); if (lane < 16) ssqp[(size_t)m * 16 + lane] = lane == 0 ? s : 0.f; }
            else { const int mm = m - M; const float s = row_to_bf16(args.in[1] + (size_t)mm * DM, xmb + (size_t)mm * DM, lane); if (lane == 0) ssqm1[mm] = s; }
        }
        { const int gt = bx * 512 + tid, NGT = G * 512;
          if (gt < 16) ssqm2[gt] = 0.f;
          for (int i = gt; i < (8 * 64 * 96) / 8; i += NGT) ((u32x4*)kfm)[i] = (u32x4){0u, 0u, 0u, 0u};
          for (int i = gt; i < (8 * 64 * 64) / 8; i += NGT) ((u32x4*)vtmm)[i] = (u32x4){0u, 0u, 0u, 0u}; }
    }
#endif
    if (args.ws == nullptr) grid.sync();
    xbar = xcd_barrier_post((unsigned*)(args.ws + WS_BAR), MISC);
    GSYNC();
#ifdef PROBE_SYNC10
    GSYNC(); GSYNC(); GSYNC(); GSYNC(); GSYNC(); GSYNC(); GSYNC(); GSYNC(); GSYNC(); GSYNC();
#endif

#define META_REDUCE1(A0) { LAS f32x4* red_ = (LAS f32x4*)lds; red_[wave * 64 + lane] = A0; __syncthreads(); \
            if (wave == 0) { A0 = red_[lane]; _Pragma("unroll") for (int w_ = 1; w_ < 8; ++w_) A0 += red_[w_ * 64 + lane]; } }
#define META_REDUCE(A0, A1) { LAS f32x4* red_ = (LAS f32x4*)lds; red_[(wave * 2 + 0) * 64 + lane] = A0; red_[(wave * 2 + 1) * 64 + lane] = A1; __syncthreads(); \
            if (wave == 0) { A0 = red_[lane]; A1 = red_[64 + lane]; _Pragma("unroll") for (int w_ = 1; w_ < 8; ++w_) { A0 += red_[(w_ * 2) * 64 + lane]; A1 += red_[(w_ * 2 + 1) * 64 + lane]; } } }
#pragma unroll
    for (int rep = 0; rep < 2; ++rep) {
        { PH_BEGIN
        if (rep == 0) {
            for (int task = bx; task < 176; task += G) { const int a0 = 16 * task, tile = a0 >> 7, j = a0 & 127, n0 = 256 * tile + j;
                f32x4 g, u; const bf16_t* wp = Wb + W_GU1 + (size_t)(n0 + r16) * 1024 + 8 * q4 + 128 * wave; skinny_tile(xmb + r16 * 1024 + 8 * q4 + 128 * wave, wp, wp + 128 * 1024, 128, g, u);
                META_REDUCE(g, u)
                if (wave == 0) {
                const float rs = 1.f;
                u32x2 w; w.x = pk2(silu_f(g[0] * rs) * (u[0] * rs), silu_f(g[1] * rs) * (u[1] * rs)); w.y = pk2(silu_f(g[2] * rs) * (u[2] * rs), silu_f(g[3] * rs) * (u[3] * rs));
                *(u32x2*)(actm + r16 * FF + a0 + 4 * q4) = w; }
                __syncthreads(); }
        }
#if (GEMM_MASK >> 0) & 1
        { pg8::Gemm g{HB, Wb + (rep ? W_GU2 : W_GU1), 1024, 1024, 1024}; pg8::StaticOrder S; S.init(M / 256, 22, G, bx); EpiSwiGLU E{ACT, rep ? ssqp : nullptr, lds, -1};
          pg8::gemm_phase<EpiSwiGLU, pg8::StaticOrder, true, true>(lds, g, S, E); }
#ifdef PROBE_GU2
        if (rep == 0) { pg8::Gemm g{HB, Wb + (rep ? W_GU2 : W_GU1), 1024, 1024, 1024}; pg8::StaticOrder S; S.init(M / 256, 22, G, bx); EpiSwiGLU E{ACT, rep ? ssqp : nullptr, lds, -1};
          pg8::gemm_phase<EpiSwiGLU, pg8::StaticOrder, true, true>(lds, g, S, E); }
#endif
#endif
        }
        GSYNC();
        { PH_BEGIN
        if (rep == 0) {
            for (int task = bx; task < 64; task += G) { const int n0 = 16 * task; f32x4 a, dmy; skinny_tile(actm + r16 * FF + 8 * q4 + 352 * wave, Wb + W_D1 + (size_t)(n0 + r16) * FF + 8 * q4 + 352 * wave, nullptr, 352, a, dmy);
                META_REDUCE1(a)
                if (wave == 0) {
                const size_t off = (size_t)r16 * 1024 + n0 + 4 * q4; const f32x4 v = *(const f32x4*)(args.in[1] + off) + 0.5f * a; *(f32x4*)(hm + off) = v;
                u32x2 w; w.x = pk2(v[0], v[1]); w.y = pk2(v[2], v[3]); *(u32x2*)(hmb + off) = w;
                float s = sumsq4(v); s += __shfl_xor(s, 16); s += __shfl_xor(s, 32); if (q4 == 0) atomicAdd(ssqm2 + r16, s); }
                __syncthreads(); }
        }
#if (GEMM_MASK >> 1) & 1
        { pg8::Gemm g{ACT, Wb + (rep ? W_D2 : W_D1), FF, FF, FF}; pg8::StaticOrder S; S.init(M / 256, 4, G, bx);
          EpiResid E{rep ? (const void*)HB : (const void*)x, rep, rep ? out : nullptr, rep ? nullptr : (bf16_t*)out, rep ? nullptr : ssqp, 0.5f};
          pg8::gemm_phase<EpiResid, pg8::StaticOrder, true, true>(lds, g, S, E); }
#endif
        }
        if (rep == 1) break;
        GSYNC();
        { PH_BEGIN
        for (int task = bx; task < 272; task += G) { const int n0 = 16 * task; f32x4 a, dmy;
            const bf16_t* wp = (n0 < 3840 ? Wb + W_IN + (size_t)(n0 + r16) * 1024 : Wb + W_INV + (size_t)(n0 - 3840 + r16) * 1024) + 8 * q4 + 128 * wave;
            skinny_tile(hmb + r16 * 1024 + 8 * q4 + 128 * wave, wp, nullptr, 128, a, dmy);
            META_REDUCE1(a)
            if (wave == 0) {
            const float rs = __builtin_amdgcn_rsqf(ld_agent(ssqm2 + r16) * (1.f / 1024.f) + EPS); const f32x4 v = a * rs; const size_t off = (size_t)r16 * 4352 + n0 + 4 * q4;
            *(f32x4*)(projm + off) = v; u32x2 w; w.x = pk2(v[0], v[1]); w.y = pk2(v[2], v[3]); *(u32x2*)(projmb + off) = w; }
            __syncthreads(); }
#if (GEMM_MASK >> 2) & 1
        { pg8::Gemm g{(const bf16_t*)out, Wb + W_IN, 1024, 1024, 1024}; pg8::StaticOrder S; S.init(M / 256, 15, G, bx);
          EpiProj E{ssqp, CQ, CKV, QN, KN, SGA, SGB, cqs, ckvs, args.in[14], args.in[15], lds, -1};
          pg8::gemm_phase<EpiProj, pg8::StaticOrder, true, true>(lds, g, S, E); }
#endif
#if (GEMM_MASK >> 3) & 1
        { pg8::Gemm g{Wb + W_INV, (const bf16_t*)out, 1024, 1024, 1024}; pg8::StaticOrder S; S.init(2, M / 256, G, bx); EpiColT<16> E{VTN, M, ssqp, 1.f / 1024.f};
          pg8::gemm_phase<EpiColT<16>, pg8::StaticOrder, true, true>(lds, g, S, E); }
#endif
        }
        GSYNC();
        { PH_BEGIN
        for (int task = gw; task < 64; task += NGW) { const int isv = task >= 32, n0 = 16 * (task & 31); f32x4 a, dmy;
            float s = 0.f; { const float* cp = projm + (size_t)r16 * 4352 + 512 + 64 * q4;
#pragma unroll 4
                for (int i = 0; i < 64; i += 4) s += sumsq4(*(const f32x4*)(cp + i)); }
            s += __shfl_xor(s, 16); s += __shfl_xor(s, 32); const float rs = __builtin_amdgcn_rsqf(s * (1.f / 256.f) + EPS);
            skinny_tile(projmb + (size_t)r16 * 4352 + 512 + 8 * q4, Wb + (isv ? W_UV : W_UK) + (size_t)(n0 + r16) * 256 + 8 * q4, nullptr, 256, a, dmy);
            *(f32x4*)((isv ? kvmv : kvmk) + (size_t)r16 * 512 + n0 + 4 * q4) = a * rs; }
#if (GEMM_MASK >> 4) & 1
        { pg8::Gemm g{CQ, Wb + W_UQ, 512, 384, 384}; pg8::StaticOrder S; S.init(M / 256, 4, G, bx); EpiRowScale<8> E{QRAW, 1024, cqs, 1.f / 384.f};
          pg8::gemm_phase<EpiRowScale<8>, pg8::StaticOrder, true, true>(lds, g, S, E); }
#endif
#if (GEMM_MASK >> 5) & 1
        { pg8::Gemm g{CKV, Wb + W_UK, 256, 256, 256}; pg8::StaticOrder S; S.init(M / 256, 2, G, bx); EpiRowScale<4> E{KRAW, 512, ckvs, 1.f / 256.f};
          pg8::gemm_phase<EpiRowScale<4>, pg8::StaticOrder, true, true>(lds, g, S, E); }
#endif
#if (GEMM_MASK >> 6) & 1
        { pg8::Gemm g{Wb + W_UV, CKV, 256, 256, 256}; pg8::StaticOrder S; S.init(2, M / 256, G, bx); EpiColT<4> E{VTM, M, ckvs, 1.f / 256.f};
          pg8::gemm_phase<EpiColT<4>, pg8::StaticOrder, true, true>(lds, g, S, E); }
#endif
        }
        GSYNC();
        { PH_BEGIN
            const float* qg = args.in[12]; const float* kg = args.in[13];
            const int hh = lane >> 3, sub = lane & 7;
            for (int row = gw; row < M; row += NGW) {
                const int b = row >> 12, t = row & 4095, pos = 16 + t;
                float c0, s0, c1, s1; rope_cs(pos, 2 * sub, c0, s0); rope_cs(pos, 2 * sub + 1, c1, s1);
#pragma unroll
                for (int isk = 0; isk < 2; ++isk) {
                    const bf16_t* np = isk ? KRAW + (size_t)row * 512 + 64 * hh + 8 * sub : QRAW + (size_t)row * 1024 + 128 * hh + 8 * sub;
                    const bf16_t* rp = isk ? CQ + (size_t)row * 512 + 384 + 2 * sub : QRAW + (size_t)row * 1024 + 128 * hh + 64 + 2 * sub;
                    const u32x4 nv = *(const u32x4*)np; const unsigned lo = *(const unsigned*)rp, hi2 = *(const unsigned*)(rp + 16);
                    float v[8]; v[0] = __uint_as_float(nv.x << 16); v[1] = __uint_as_float(nv.x & 0xffff0000u); v[2] = __uint_as_float(nv.y << 16); v[3] = __uint_as_float(nv.y & 0xffff0000u);
                    v[4] = __uint_as_float(nv.z << 16); v[5] = __uint_as_float(nv.z & 0xffff0000u); v[6] = __uint_as_float(nv.w << 16); v[7] = __uint_as_float(nv.w & 0xffff0000u);
                    float a0 = __uint_as_float(lo << 16), a1 = __uint_as_float(lo & 0xffff0000u), b0 = __uint_as_float(hi2 << 16), b1 = __uint_as_float(hi2 & 0xffff0000u);
                    float s = (a0 * a0 + a1 * a1) + (b0 * b0 + b1 * b1);
#pragma unroll
                    for (int i = 0; i < 8; ++i) s += v[i] * v[i];
                    s += __shfl_xor(s, 1); s += __shfl_xor(s, 2); s += __shfl_xor(s, 4);
                    const float* gn = isk ? kg : qg;
                    const float rs = __builtin_amdgcn_rsqf(s * (1.f / 96.f) + EPS) * (isk ? 1.f : QSC_MLA);
                    const f32x4 g0 = *(const f32x4*)(gn + 8 * sub), g1 = *(const f32x4*)(gn + 8 * sub + 4);
                    const f32x2 gl = *(const f32x2*)(gn + 64 + 2 * sub), gh = *(const f32x2*)(gn + 80 + 2 * sub);
                    f32x4 o0, o1;
#pragma unroll
                    for (int i = 0; i < 4; ++i) { o0[i] = v[i] * rs * g0[i]; o1[i] = v[4 + i] * rs * g1[i]; }
                    a0 *= rs * gl[0]; a1 *= rs * gl[1]; b0 *= rs * gh[0]; b1 *= rs * gh[1];
                    const float l0 = a0 * c0 - b0 * s0, l1 = a1 * c1 - b1 * s1, h0 = a0 * s0 + b0 * c0, h1 = a1 * s1 + b1 * c1;
                    if (isk) { const int kap = swap23(t & 63), sw = (kap >> 2) & 3;
                        unsigned char* kt = (unsigned char*)KF + ((size_t)(b * 8 + hh) * 64 + (t >> 6)) * MLA_KT + kap * 192;
                        st16((bf16_t*)(kt + 16 * (sub ^ sw)), o0, o1); *(unsigned*)(kt + 16 * ((8 + (sub >> 2)) ^ sw) + 4 * (sub & 3)) = pk2(l0, l1); *(unsigned*)(kt + 16 * ((10 + (sub >> 2)) ^ sw) + 4 * (sub & 3)) = pk2(h0, h1);
                    } else { bf16_t* dst = QRAW + (size_t)row * 1024 + 128 * hh;
                        st16(dst + 8 * sub, o0, o1); *(unsigned*)(dst + 64 + 2 * sub) = pk2(l0, l1); *(unsigned*)(dst + 80 + 2 * sub) = pk2(h0, h1); }
                }
            }
            for (int task = gw; task < 128; task += NGW) {
                const int m = task >> 3, h = task & 7;
                const float kn_ = kvmk[(size_t)m * 512 + 64 * h + lane]; const float kr = lane < 32 ? projm[(size_t)m * 4352 + 384 + lane] : 0.f;
                const float rs = __builtin_amdgcn_rsqf(wave_sum(kn_ * kn_ + kr * kr) * (1.f / 96.f) + EPS);
                const int kapm = swap23(m), swm = (kapm >> 2) & 3; bf16_t* kmrow = kfm + ((size_t)h * 64 + kapm) * 96;
                kmrow[8 * ((lane >> 3) ^ swm) + (lane & 7)] = (bf16_t)(pk2(kn_ * rs * kg[lane], 0.f) & 0xffffu);
                const float xr = kr * rs * kg[64 + (lane & 31)]; const float pr = __shfl_xor(xr, 16);
                float c, s; rope_cs(m, lane & 15, c, s);
                const float orp = (lane & 16) ? (pr * s + xr * c) : (xr * c - pr * s);
                if (lane < 32) kmrow[8 * ((8 + (lane >> 3)) ^ swm) + (lane & 7)] = (bf16_t)(pk2(orp, 0.f) & 0xffffu);
                vtmm[((size_t)h * 64 + lane) * 64 + m] = (bf16_t)(pk2(kvmv[(size_t)m * 512 + 64 * h + lane], 0.f) & 0xffffu);
                const int colp = 1280 + 256 * (h >> 2) + 128 * (lane >> 5) + 32 * (h & 3) + (lane & 31);
                const float kv = projm[(size_t)m * 4352 + colp]; const float rn = __builtin_amdgcn_rsqf(wave_sum(kv * kv) * (1.f / 64.f) + EPS);
                knm[(size_t)m * 512 + 64 * h + lane] = (bf16_t)(pk2(kv * rn * args.in[15][lane], 0.f) & 0xffffu);
                vnmT[((size_t)64 * h + lane) * 16 + m] = (bf16_t)(pk2(projm[(size_t)m * 4352 + 3840 + 64 * h + lane], 0.f) & 0xffffu);
            }
        }
        GSYNC();
        { PH_BEGIN
#ifndef NO_MLA
        {
            LAS float* scr = (LAS float*)(lds + wave * 16384);
        constexpr int I_GU = 16 * 176, I_D = 44 * 32, I_IN = 16 * 120, I_INV = 16 * 16, I_UQ = 6 * 32, I_UK = 4 * 16, I_AB = 8 * 32, I_O = 16 * 32;
        constexpr int NITEMS = 2 * I_GU + 2 * I_D + I_IN + I_INV + I_UQ + 2 * I_UK + 2 * I_AB + I_O;
        for (int it = gw; it < NITEMS; it += NGW) {
            int r = it;
            { const bool late_ = (it >= I_GU && it < 2 * I_GU) || (it >= 2 * I_GU + I_D && it < 2 * I_GU + 2 * I_D) || it >= 2 * I_GU + 2 * I_D + I_IN + I_INV + I_UQ + 2 * I_UK; if (!late_) continue; }
            if (r < 2 * I_GU) { const int l2 = r >= I_GU; if (l2) r -= I_GU; const int kb = r / 176, nb = r % 176, n0 = 32 * nb, tile = n0 >> 8, half = (n0 >> 7) & 1, j = n0 & 127;
                const float* W = args.in[(l2 ? 21 : 3) + half]; tr_item(W, FF, 1024, args.in[l2 ? 20 : 2], Wb + (l2 ? W_GU2 : W_GU1), n0, 128 * tile + j, 64 * kb, scr, lane); continue; }
            r -= 2 * I_GU;
            if (r < 2 * I_D) { const int l2 = r >= I_D; if (l2) r -= I_D; const int kb = r / 32, nb = r % 32;
                tr_item(args.in[l2 ? 23 : 5], 1024, FF, nullptr, Wb + (l2 ? W_D2 : W_D1), 32 * nb, 32 * nb, 64 * kb, scr, lane); continue; }
            r -= 2 * I_D;
            if (r < I_IN) { const int kb = r / 120, nb = r % 120, n0 = 32 * nb; int src;
                if (n0 < 384) src = n0; else if (n0 < 416) src = 640 + (n0 - 384); else if (n0 < 512) src = -1; else if (n0 < 768) src = 384 + (n0 - 512);
                else if (n0 < 1792) { const bool isq = n0 < 1280; const int c = n0 - (isq ? 768 : 1280), t = c >> 8, cc = c & 255, bj = cc >> 7, wc = (cc & 127) >> 5; src = (isq ? 672 : 1184) + 64 * (4 * t + wc) + 32 * bj; }
                else if (n0 < 2816) src = 2208 + (n0 - 1792); else src = 3232 + (n0 - 2816);
                tr_item(args.in[7], 4256, 1024, args.in[6], Wb + W_IN, n0, src, 64 * kb, scr, lane); continue; }
            r -= I_IN;
            if (r < I_INV) { const int kb = r / 16, nb = r % 16; tr_item(args.in[7], 4256, 1024, args.in[6], Wb + W_INV, 32 * nb, 1696 + 32 * nb, 64 * kb, scr, lane); continue; }
            r -= I_INV;
            if (r < I_UQ) { const int kb = r / 32, nb = r % 32, n0 = 32 * nb, hh = n0 >> 7, j = n0 & 127; tr_item(args.in[9], 768, 384, args.in[8], Wb + W_UQ, n0, j < 96 ? 96 * hh + j : -1, 64 * kb, scr, lane); continue; }
            r -= I_UQ;
            if (r < 2 * I_UK) { const int isv = r >= I_UK; if (isv) r -= I_UK; const int kb = r / 16, nb = r % 16, n0 = 32 * nb, hh = n0 >> 6, j = n0 & 63;
                tr_item(args.in[11], 1024, 256, args.in[10], Wb + (isv ? W_UV : W_UK), n0, 128 * hh + (isv ? 64 : 0) + j, 64 * kb, scr, lane); continue; }
            r -= 2 * I_UK;
            if (r < 2 * I_AB) { const int isb = r >= I_AB; if (isb) r -= I_AB; const int kb = r / 32, nb = r % 32; tr_item(args.in[isb ? 18 : 17], 1024, 512, nullptr, Wb + (isb ? W_B : W_A), 32 * nb, 32 * nb, 64 * kb, scr, lane); continue; }
            r -= 2 * I_AB;
            { const int kb = r / 32, nb = r % 32; tr_item(args.in[19], 1024, 1024, nullptr, Wb + W_O, 32 * nb, 32 * nb, 64 * kb, scr, lane); }
        }
        }
        for (int i = tid; i < 8 * 465; i += 512) ((LAS float*)(lds + NA_BIAS_OFF))[i] = args.in[16][i] * LOG2E;
        __syncthreads();
        bool fix_mla, fix_na;
        { const float* qg = args.in[12]; const float* kg = args.in[13]; float a = fmaxf(fabsf(qg[lane]), lane < 32 ? fabsf(qg[64 + lane]) : 0.f), c = fmaxf(fabsf(kg[lane]), lane < 32 ? fabsf(kg[64 + lane]) : 0.f);
#pragma unroll
          for (int o_ = 1; o_ < 64; o_ <<= 1) { a = fmaxf(a, __shfl_xor(a, o_)); c = fmaxf(c, __shfl_xor(c, o_)); }
          fix_mla = __builtin_amdgcn_readfirstlane((int)(96.f * a * c * QSC_MLA < 60.f)) != 0;
          float e = fabsf(args.in[14][lane]), f = fabsf(args.in[15][lane]), g = 0.f;
          for (int i = lane; i < 8 * 465; i += 64) g = fmaxf(g, fabsf(args.in[16][i]));
#pragma unroll
          for (int o_ = 1; o_ < 64; o_ <<= 1) { e = fmaxf(e, __shfl_xor(e, o_)); f = fmaxf(f, __shfl_xor(f, o_)); g = fmaxf(g, __shfl_xor(g, o_)); }
          fix_na = __builtin_amdgcn_readfirstlane((int)(64.f * e * f * QSC_NA + g * LOG2E < 60.f)) != 0; }
#ifdef PROBE_MLA2
        for (int unit = bx; unit < 1024; unit += G) { const int bh = unit >> 4, qb = unit & 15; mla_unit(false, lds, bh >> 3, bh & 7, qb, QRAW, KF, kfm, VTM, vtmm, OA, tid, lane, wave); }
#endif
#define MLA_UNITS(FX) for (int unit = bx; unit < 1024; unit += G) { int bh = unit >> 4, qb = unit & 15; \
            if (G == 256) { const int xcd = bx & 7, slot = bx >> 3; bh = 16 * (unit >> 8) + 2 * xcd + (slot >> 4); qb = slot & 15; }     \
            mla_unit(FX, lds, bh >> 3, bh & 7, qb, QRAW, KF, kfm, VTM, vtmm, OA, tid, lane, wave); }
#if defined(T_MLA_T)
        MLA_UNITS(true)
#elif defined(T_MLA_F)
        MLA_UNITS(false)
#elif defined(T_MLA_N)
#else
#ifdef PROBE_NOFIX
        fix_mla = false; fix_na = false;
#endif
        MLA_UNITS(fix_mla)
#endif
#undef MLA_UNITS
#endif
#ifndef NO_NA
#define NA_UNITS(FX) for (int unit = ((G % 8 == 0) ? ((bx & 7) * (G >> 3) + (bx >> 3)) * 8 + wave : gw); unit < 4096; unit += NGW) { const int r = unit & 63, bh = unit >> 6;     na_unit<FX>(lds, lds + wave * 16384, bh >> 3, bh & 7, r, QN, KN, VTN, knm, vnmT, OB, lane); }
#if defined(T_NA_T)
        NA_UNITS(true)
#elif defined(T_NA_F)
        NA_UNITS(false)
#elif defined(T_NA_N)
#else
        if (fix_na) { NA_UNITS(true) } else { NA_UNITS(false) }
#ifdef PROBE_NA2
        NA_UNITS(fix_na)
#endif
#endif
#undef NA_UNITS
#endif
        }
        GSYNC();
        { PH_BEGIN
#if (GEMM_MASK >> 7) & 1
        for (int br = 0; br < 2; ++br) { pg8::Gemm g{br ? OB : OA, Wb + (br ? W_B : W_A), 512, 512, 512}; pg8::StaticOrder S; S.init(M / 256, 4, G, bx); EpiGate E{MERGED, br ? SGB : SGA, br};
          pg8::gemm_phase<EpiGate, pg8::StaticOrder, true, true>(lds, g, S, E); }
#endif
        }
        GSYNC();
        { PH_BEGIN
#if (GEMM_MASK >> 8) & 1
        { pg8::Gemm g{MERGED, Wb + W_O, 1024, 1024, 1024}; pg8::StaticOrder S; S.init(M / 256, 4, G, bx); EpiResid E{(const void*)out, 1, nullptr, HB, ssqp, 1.f};
          pg8::gemm_phase<EpiResid, pg8::StaticOrder, true, true>(lds, g, S, E); }
#endif
        }
        GSYNC();
    }
}

extern "C" void kernel_launch(void* const* d_in, const int* in_sizes, int n_in, void* d_out, int out_size, void* d_ws, size_t ws_size, hipStream_t stream) {
    static int grid = 0;
    if (grid == 0) {
        if (n_in != 24 || out_size != M * DM || ws_size < WS_END) { fprintf(stderr, "kernel_launch: unexpected shapes (n_in %d out %d ws %zu)\n", n_in, out_size, ws_size); grid = -1; return; }
        int dev = 0, cus = 0, per_cu = 0;
        hipGetDevice(&dev); hipDeviceGetAttribute(&cus, hipDeviceAttributeMultiprocessorCount, dev);
        hipFuncSetAttribute((const void*)mega_fwd, hipFuncAttributeMaxDynamicSharedMemorySize, LDS_BYTES);
        hipOccupancyMaxActiveBlocksPerMultiprocessor(&per_cu, (const void*)mega_fwd, 512, LDS_BYTES);
        if (per_cu < 1) per_cu = 1;
        grid = cus * per_cu; if (grid > 256) grid = 256;
        (void)hipGetLastError();
    }
    if (grid < 0) return;
    if (hipMemsetAsync((char*)d_ws + WS_BAR, 0, XCD_BAR_WORDS * 4, stream) != hipSuccess) { fprintf(stderr, "kernel_launch: memset of the barrier words failed\n"); return; }
    Args a{};
    for (int i = 0; i < 24; ++i) a.in[i] = (const float*)d_in[i];
    a.out = (float*)d_out; a.ws = (unsigned char*)d_ws;
    void* kargs[] = {&a};
    hipError_t e = hipLaunchCooperativeKernel((const void*)mega_fwd, dim3(grid), dim3(512), kargs, LDS_BYTES, stream);
    if (e != hipSuccess) fprintf(stderr, "cooperative launch failed: %s (grid %d)\n", hipGetErrorString(e), grid);
}
```
